# Optimizing an MI355X kernel written in HIP

```python
import jax, jax.numpy as jnp
from jax import lax
import numpy as np

D_MODEL = 1024
BATCH = 8
SEQ = 4096
DEPTH = 2

CTX_LEN = 256
GRID_W = 64
N_MIXERS = 2
NA_HEADS = 16
NA_HEAD_DIM = D_MODEL // NA_HEADS
NA_WIN_ROWS = 8
NA_WIN_COLS = 16
NA_QBLK_COLS = 16
NA_KBLK_COLS = 32
ML_HEADS = 8
ML_QK_DIM = 64
ML_V_DIM = 128
ML_CHUNK = 64
ML_QK_W = ML_HEADS * ML_QK_DIM
ML_V_W = ML_HEADS * ML_V_DIM
ML_IN_W = 2 * ML_QK_W + 2 * ML_V_W + 4 * ML_HEADS
ROPE_BASE = 10000.0
N_EXPERTS = 16
EC_CAPACITY = 2
EXPERT_HIDDEN = 2 * D_MODEL
EPS = 1e-6
NEG = -1e30
N_NA_LAYERS = (DEPTH + 1) // 2
N_ML_LAYERS = DEPTH // 2

kernel_name = 'hybrid_na_mlstm_ec_moe_dit'


def rms_norm(x, g):
    xf = x.astype(jnp.float32)
    y = xf * lax.rsqrt(jnp.mean(xf * xf, axis=-1, keepdims=True) + EPS)
    return (y * g.astype(jnp.float32)).astype(x.dtype)


def _rope_angles(pos, n_dims):
    inv = ROPE_BASE ** (-jnp.arange(0, n_dims, 2, dtype=jnp.float32) / n_dims)
    return pos.astype(jnp.float32)[:, None] * inv[None, :]


def _rotate(x, ang):
    x1, x2 = jnp.split(x, 2, axis=-1)
    cos = jnp.cos(ang)[None, :, None, :]
    sin = jnp.sin(ang)[None, :, None, :]
    return jnp.concatenate([x1 * cos - x2 * sin, x1 * sin + x2 * cos], axis=-1)


def rope_2d(x):
    t = jnp.arange(x.shape[1])
    half = x.shape[-1] // 2
    xr = _rotate(x[..., :half], _rope_angles(t // GRID_W, half))
    xc = _rotate(x[..., half:], _rope_angles(t % GRID_W, half))
    return jnp.concatenate([xr, xc], axis=-1).astype(x.dtype)


def neighbourhood_attention(h_lat, h_ctx, w_qkv, w_out, rel_bias, with_ctx_out):
    B, n, D = h_lat.shape
    rows = n // GRID_W
    wr = min(NA_WIN_ROWS, rows)
    n_qb = GRID_W // NA_QBLK_COLS
    hd = (NA_HEADS, NA_HEAD_DIM)
    scale = NA_HEAD_DIM ** -0.5
    q, k, v = jnp.split(h_lat @ w_qkv, 3, axis=-1)
    q = (q * scale).reshape((B, rows, GRID_W) + hd)
    k = k.reshape((B, rows, GRID_W) + hd)
    v = v.reshape((B, rows, GRID_W) + hd)
    q_c, k_c, v_c = jnp.split(h_ctx @ w_qkv, 3, axis=-1)
    q_c = (q_c * scale).reshape((B, CTX_LEN) + hd)
    k_c = k_c.reshape((B, CTX_LEN) + hd)
    v_c = v_c.reshape((B, CTX_LEN) + hd)

    q_col = np.arange(GRID_W).reshape(n_qb, NA_QBLK_COLS)
    win_c0 = np.clip(q_col - NA_WIN_COLS // 2, 0, GRID_W - NA_WIN_COLS)
    k_col = np.clip(q_col[:, :1] - NA_WIN_COLS // 2, 0, GRID_W - NA_KBLK_COLS) + np.arange(NA_KBLK_COLS)
    in_win = (k_col[:, None, :] >= win_c0[:, :, None]) & (k_col[:, None, :] < win_c0[:, :, None] + NA_WIN_COLS)
    dc_idx = np.clip(k_col[:, None, :] - q_col[:, :, None] + NA_WIN_COLS - 1, 0, 2 * NA_WIN_COLS - 2)
    col_bias = jnp.where(in_win, rel_bias.astype(jnp.float32)[:, :, dc_idx], NEG)

    def row_block(args):
        r, q_r = args
        r0 = jnp.clip(r - wr // 2, 0, rows - wr)
        k_blk = lax.dynamic_slice_in_dim(k, r0, wr, axis=1)[:, :, k_col]
        v_blk = lax.dynamic_slice_in_dim(v, r0, wr, axis=1)[:, :, k_col]
        q_blk = q_r.reshape((B, n_qb, NA_QBLK_COLS) + hd)
        bias = col_bias[:, r0 + jnp.arange(wr) - r + NA_WIN_ROWS - 1]
        bias = jnp.transpose(bias, (0, 2, 3, 1, 4))[None]
        s_win = jnp.einsum('bjqhd,bwjkhd->bhjqwk', q_blk, k_blk).astype(jnp.float32) + bias
        s_ctx = jnp.einsum('bjqhd,bkhd->bhjqk', q_blk, k_c).astype(jnp.float32)
        n_win = wr * NA_KBLK_COLS
        s = jnp.concatenate([s_win.reshape(B, NA_HEADS, n_qb, NA_QBLK_COLS, n_win), s_ctx], axis=-1)
        p = jax.nn.softmax(s, axis=-1).astype(v.dtype)
        p_win = p[..., :n_win].reshape(B, NA_HEADS, n_qb, NA_QBLK_COLS, wr, NA_KBLK_COLS)
        o = (jnp.einsum('bhjqwk,bwjkhd->bjqhd', p_win, v_blk)
             + jnp.einsum('bhjqk,bkhd->bjqhd', p[..., n_win:], v_c))
        return o.reshape(B, GRID_W, D)

    o_lat = lax.map(row_block, (jnp.arange(rows), jnp.moveaxis(q, 1, 0)))
    y_lat = jnp.moveaxis(o_lat, 0, 1).reshape(B, n, D) @ w_out
    y_ctx = None
    if with_ctx_out:
        s = jnp.einsum('bqhd,bkhd->bhqk', q_c, k_c).astype(jnp.float32)
        p = jax.nn.softmax(s, axis=-1).astype(v_c.dtype)
        y_ctx = jnp.einsum('bhqk,bkhd->bqhd', p, v_c).reshape(B, CTX_LEN, D) @ w_out
    return y_lat, y_ctx


def mlstm_scan(q, k, v, i_pre, logf, state):
    B, G, T, _ = q.shape
    dv = v.shape[-1]
    nc = T // ML_CHUNK
    causal = jnp.tril(jnp.ones((ML_CHUNK, ML_CHUNK), dtype=bool))

    def chunks(t):
        return jnp.moveaxis(t.astype(jnp.float32).reshape((B, G, nc, ML_CHUNK) + t.shape[3:]), 2, 0)

    def step(carry, xs):
        C, nv, m = carry
        qc, kc, vc, ic, fc = xs
        b = jnp.cumsum(fc, axis=-1)
        dmat = jnp.where(causal, b[..., :, None] - b[..., None, :] + ic[..., None, :], NEG)
        inter = b + m[..., None]
        m_row = jnp.maximum(dmat.max(axis=-1), inter)
        w_inter = jnp.exp(inter - m_row)
        s = jnp.einsum('bgtd,bgsd->bgts', qc, kc) * jnp.exp(dmat - m_row[..., None])
        num = jnp.einsum('bgts,bgsv->bgtv', s, vc) + w_inter[..., None] * jnp.einsum('bgtd,bgdv->bgtv', qc, C)
        den = s.sum(axis=-1) + w_inter * jnp.einsum('bgtd,bgd->bgt', qc, nv)
        h = num / jnp.maximum(jnp.abs(den), jnp.exp(-m_row))[..., None]
        b_end = b[..., -1]
        g = b_end[..., None] - b + ic
        m_new = jnp.maximum(b_end + m, g.max(axis=-1))
        w_k = jnp.exp(g - m_new[..., None])
        decay = jnp.exp(b_end + m - m_new)
        C_new = decay[..., None, None] * C + jnp.einsum('bgs,bgsd,bgsv->bgdv', w_k, kc, vc)
        n_new = decay[..., None] * nv + jnp.einsum('bgs,bgsd->bgd', w_k, kc)
        return (C_new, n_new, m_new), h

    state, h = lax.scan(step, state, (chunks(q), chunks(k), chunks(v), chunks(i_pre), chunks(logf)))
    return jnp.moveaxis(h, 0, 2).reshape(B, G, T, dv), state


def _bidir(q, k, v, i_pre, logf):
    B, T = q.shape[:2]

    def heads(t):
        t = jnp.moveaxis(t, 1, 2)
        return jnp.concatenate([t, jnp.flip(t, axis=2)], axis=1)

    def gates(g):
        g = jnp.transpose(g, (0, 2, 3, 1))
        return jnp.stack([g[:, 0], jnp.flip(g[:, 1], axis=-1)], axis=1).reshape(B, 2 * ML_HEADS, T)

    return heads(q), heads(k), heads(v), gates(i_pre), gates(logf)


def mlstm_mixer(h_lat, h_ctx, w_in, b_gate, norm_w, w_out, with_ctx_out):
    B = h_lat.shape[0]
    splits = [ML_QK_W, 2 * ML_QK_W, 2 * ML_QK_W + ML_V_W, 2 * ML_QK_W + 2 * ML_V_W]

    def project(h):
        T = h.shape[1]
        q, k, v, o, g = jnp.split(h @ w_in, splits, axis=-1)
        g = g.astype(jnp.float32) + b_gate.astype(jnp.float32)
        i_pre = g[..., :2 * ML_HEADS].reshape(B, T, 2, ML_HEADS)
        logf = jax.nn.log_sigmoid(g[..., 2 * ML_HEADS:]).reshape(B, T, 2, ML_HEADS)
        q = q.reshape(B, T, ML_HEADS, ML_QK_DIM)
        k = k.reshape(B, T, ML_HEADS, ML_QK_DIM) * (ML_QK_DIM ** -0.5)
        v = v.reshape(B, T, ML_HEADS, ML_V_DIM)
        return q, k, v, o, i_pre, logf

    def readout(h, o):
        T = h.shape[2]
        hs = h[:, :ML_HEADS] + jnp.flip(h[:, ML_HEADS:], axis=2)
        hs = jnp.moveaxis(hs, 1, 2)
        hs = hs * lax.rsqrt(jnp.mean(hs * hs, axis=-1, keepdims=True) + EPS)
        hs = hs.reshape(B, T, ML_V_W) * norm_w.astype(jnp.float32)
        return (hs * jax.nn.sigmoid(o.astype(jnp.float32))).astype(h_lat.dtype) @ w_out

    G = 2 * ML_HEADS
    init = (jnp.zeros((B, G, ML_QK_DIM, ML_V_DIM), jnp.float32),
            jnp.zeros((B, G, ML_QK_DIM), jnp.float32),
            jnp.full((B, G), NEG, jnp.float32))
    qc, kc, vc, oc, ic, fc = project(h_ctx)
    h_c, ctx_state = mlstm_scan(*_bidir(qc, kc, vc, ic, fc), init)
    ql, kl, vl, ol, il, fl = project(h_lat)
    h_l, _ = mlstm_scan(*_bidir(rope_2d(ql), rope_2d(kl), vl, il, fl), ctx_state)
    y_ctx = readout(h_c, oc) if with_ctx_out else None
    return readout(h_l, ol), y_ctx


def expert_choice_ffn(h, w_router, w_gate, w_up, w_down):
    n = h.shape[1]
    cap = EC_CAPACITY * n // N_EXPERTS

    def one_set(hs):
        aff = jax.nn.softmax((hs @ w_router).astype(jnp.float32), axis=-1)
        gate, idx = lax.top_k(aff.T, cap)
        xe = hs[idx]
        a = jnp.einsum('ecd,edf->ecf', xe, w_gate)
        u = jnp.einsum('ecd,edf->ecf', xe, w_up)
        ye = jnp.einsum('ecf,efd->ecd', jax.nn.silu(a) * u, w_down)
        ye = ye * gate[..., None].astype(ye.dtype)
        return jnp.zeros_like(hs).at[idx].add(ye)

    return lax.map(one_set, h)


def setup_inputs(seed: int = 0) -> dict:
    key = jax.random.key(seed)
    ks = jax.random.split(key, 20)
    D, H = D_MODEL, ML_HEADS
    nrm = lambda k, s, sc: jax.random.normal(k, s, jnp.float32) * sc
    f_bias = jnp.tile(jnp.linspace(3.0, 6.0, H, dtype=jnp.float32), 2)[None] + nrm(ks[11], (N_ML_LAYERS, 2 * H), 0.1)
    return {
        'x': nrm(ks[0], (BATCH, SEQ, D), 1.0),
        'c': nrm(ks[1], (BATCH, D), 1.0),
        'ctx': nrm(ks[2], (BATCH, CTX_LEN, D), 1.0),
        'c_ctx': nrm(ks[3], (D,), 1.0),
        'ada_w': nrm(ks[4], (DEPTH, D, 6 * D), 0.5 * D ** -0.5),
        'ada_b': nrm(ks[5], (DEPTH, 6 * D), 0.02),
        'norm_g': 1.0 + nrm(ks[6], (DEPTH, 4, D), 0.02),
        'na_w_qkv': nrm(ks[7], (N_NA_LAYERS, D, 3 * D), D ** -0.5),
        'na_w_out': nrm(ks[8], (N_NA_LAYERS, D, D), D ** -0.5),
        'na_rel_bias': nrm(ks[9], (N_NA_LAYERS, NA_HEADS, 2 * NA_WIN_ROWS - 1, 2 * NA_WIN_COLS - 1), 0.1),
        'ml_w_in': nrm(ks[10], (N_ML_LAYERS, D, ML_IN_W), D ** -0.5),
        'ml_b_gate': jnp.concatenate([nrm(ks[12], (N_ML_LAYERS, 2 * H), 0.1), f_bias], axis=-1),
        'ml_norm_w': 1.0 + nrm(ks[13], (N_ML_LAYERS, ML_V_W), 0.02),
        'ml_w_out': nrm(ks[14], (N_ML_LAYERS, ML_V_W, D), ML_V_W ** -0.5),
        'moe_w_router': nrm(ks[15], (DEPTH, D, N_EXPERTS), D ** -0.5),
        'moe_w_gate': nrm(ks[16], (DEPTH, N_EXPERTS, D, EXPERT_HIDDEN), D ** -0.5),
        'moe_w_up': nrm(ks[17], (DEPTH, N_EXPERTS, D, EXPERT_HIDDEN), D ** -0.5),
        'moe_w_down': nrm(ks[18], (DEPTH, N_EXPERTS, EXPERT_HIDDEN, D), EXPERT_HIDDEN ** -0.5),
    }


def reference(x, c, ctx, c_ctx, ada_w, ada_b, norm_g, na_w_qkv, na_w_out, na_rel_bias,
              ml_w_in, ml_b_gate, ml_norm_w, ml_w_out, moe_w_router, moe_w_gate, moe_w_up, moe_w_down):
    xc = ctx
    for l in range(DEPTH):
        last = l == DEPTH - 1
        j = l // N_MIXERS
        g = norm_g[l]
        sh_m, sc_m, gt_m, sh_f, sc_f, gt_f = jnp.split((jax.nn.silu(c) @ ada_w[l] + ada_b[l])[:, None, :], 6, axis=-1)
        csh_m, csc_m, cgt_m, csh_f, csc_f, cgt_f = jnp.split(jax.nn.silu(c_ctx) @ ada_w[l] + ada_b[l], 6, axis=-1)
        h = rms_norm(x, g[0]) * (1.0 + sc_m) + sh_m
        hc = rms_norm(xc, g[0]) * (1.0 + csc_m) + csh_m
        if l % N_MIXERS == 0:
            y, yc = neighbourhood_attention(h, hc, na_w_qkv[j], na_w_out[j], na_rel_bias[j], not last)
        else:
            y, yc = mlstm_mixer(h, hc, ml_w_in[j], ml_b_gate[j], ml_norm_w[j], ml_w_out[j], not last)
        x = x + gt_m * rms_norm(y, g[1])
        h = rms_norm(x, g[2]) * (1.0 + sc_f) + sh_f
        x = x + gt_f * rms_norm(expert_choice_ffn(h, moe_w_router[l], moe_w_gate[l], moe_w_up[l], moe_w_down[l]), g[3])
        if not last:
            xc = xc + cgt_m * rms_norm(yc, g[1])
            hc = rms_norm(xc, g[2]) * (1.0 + csc_f) + csh_f
            xc = xc + cgt_f * rms_norm(expert_choice_ffn(hc, moe_w_router[l], moe_w_gate[l], moe_w_up[l], moe_w_down[l]), g[3])
    return x
```

```cpp
#include <hip/hip_runtime.h>
#include <hip/hip_cooperative_groups.h>
#include <cstdio>
#include <cstdint>
namespace cg = cooperative_groups;

#ifndef REP_PHASE
#define REP_PHASE -1
#endif
#ifndef EXTRA_SYNCS
#define EXTRA_SYNCS 0
#endif
#ifndef QKV_FP8
#define QKV_FP8 0
#endif
#ifndef MLIN_FP8
#define MLIN_FP8 1
#endif
#ifndef ONE_LAUNCH
#define ONE_LAUNCH 1
#endif

typedef unsigned short bf16_t;
typedef unsigned char fp8_t;
typedef short bf16x8 __attribute__((ext_vector_type(8)));
typedef float f32x4 __attribute__((ext_vector_type(4)));
typedef float f32x2 __attribute__((ext_vector_type(2)));
typedef unsigned u32x4 __attribute__((ext_vector_type(4)));
typedef unsigned u32x2 __attribute__((ext_vector_type(2)));
typedef __bf16 bf16x2_t __attribute__((ext_vector_type(2)));

constexpr int D = 1024, NB = 8, T = 4096, CT = 256, NL = NB * T, NC = NB * CT, R = NL + NC;
constexpr int NE = 16, HID = 2048, CAPL = 512, CAPC = 32, CAP0 = NB * CAPL + NB * CAPC  , CAP1 = NB * CAPL  ;
constexpr int MLW = 3104;
constexpr float EPS = 1e-6f;
constexpr int NTHR = 512, NWAVE = 8;
constexpr int LDS_BYTES = 163840;

struct P {
    const float *x, *c, *ctx, *c_ctx, *ada_w, *ada_b, *norm_g, *na_wqkv, *na_wout, *na_relb, *ml_win, *ml_bgate, *ml_normw, *ml_wout, *moe_wr, *moe_wg, *moe_wu, *moe_wd;
    float* out; unsigned* ctl;
    float *mod, *rope, *aff, *gatev, *gates, *xc;
    int *inv, *list;
    bf16_t *h, *q, *k, *vT, *o, *y, *h2, *XgY, *H, *qm, *km, *vm, *om, *hf, *hb, *ro, *xs;
    bf16_t *Wqkv_t, *Wo0_t, *Win_t, *Wo1_t;
    fp8_t *Wgu8, *Wd8, *h28, *Xg8, *H8, *h8, *Wqkv8, *Win8;
    float* dryx; int ph_lo, ph_hi, dry, pad_;
};

__device__ __forceinline__ int tid_() { int t = (int)threadIdx.x; asm volatile("" : "+v"(t)); return t; }
__device__ __forceinline__ unsigned pk2(float lo, float hi) { f32x2 v = {lo, hi}; bf16x2_t b = __builtin_convertvector(v, bf16x2_t); return __builtin_bit_cast(unsigned, b); }
__device__ __forceinline__ float bflo(unsigned u) { return __uint_as_float(u << 16); }
__device__ __forceinline__ float bfhi(unsigned u) { return __uint_as_float(u & 0xffff0000u); }
__device__ __forceinline__ bf16_t f2bf(float f) { return (bf16_t)(pk2(f, 0.f) & 0xffffu); }
__device__ __forceinline__ float bf2f(bf16_t h) { return __uint_as_float(((unsigned)h) << 16); }
template <int CTRL> __device__ __forceinline__ float dpp_(float v) { return __uint_as_float((unsigned)__builtin_amdgcn_update_dpp(0, (int)__float_as_uint(v), CTRL, 0xf, 0xf, true)); }
__device__ __forceinline__ float x16_sum(float v) { auto r = __builtin_amdgcn_permlane16_swap(__float_as_uint(v), __float_as_uint(v), false, false); return __uint_as_float(r[0]) + __uint_as_float(r[1]); }
__device__ __forceinline__ float x32_sum(float v) { auto r = __builtin_amdgcn_permlane32_swap(__float_as_uint(v), __float_as_uint(v), false, false); return __uint_as_float(r[0]) + __uint_as_float(r[1]); }
__device__ __forceinline__ float x16_max(float v) { auto r = __builtin_amdgcn_permlane16_swap(__float_as_uint(v), __float_as_uint(v), false, false); return fmaxf(__uint_as_float(r[0]), __uint_as_float(r[1])); }
__device__ __forceinline__ float x32_max(float v) { auto r = __builtin_amdgcn_permlane32_swap(__float_as_uint(v), __float_as_uint(v), false, false); return fmaxf(__uint_as_float(r[0]), __uint_as_float(r[1])); }
__device__ __forceinline__ float row_sum16(float v) { v += dpp_<0xB1>(v); v += dpp_<0x4E>(v); v += dpp_<0x141>(v); v += dpp_<0x140>(v); return v; }
__device__ __forceinline__ float wave_sum(float v) { v = row_sum16(v); v = x16_sum(v); return x32_sum(v); }
template <int CTRL, int RMASK> __device__ __forceinline__ float dppo_(float old, float v) { return __uint_as_float((unsigned)__builtin_amdgcn_update_dpp((int)__float_as_uint(old), (int)__float_as_uint(v), CTRL, RMASK, 0xf, false)); }
__device__ __forceinline__ float wave_scan_add(float x) {
    x += dppo_<0x111, 0xf>(0.f, x); x += dppo_<0x112, 0xf>(0.f, x); x += dppo_<0x114, 0xf>(0.f, x); x += dppo_<0x118, 0xf>(0.f, x);
    x += dppo_<0x142, 0xa>(0.f, x); x += dppo_<0x143, 0xc>(0.f, x); return x;
}
__device__ __forceinline__ float wave_scan_max(float x) {
    x = fmaxf(x, dppo_<0x111, 0xf>(-3e38f, x)); x = fmaxf(x, dppo_<0x112, 0xf>(-3e38f, x)); x = fmaxf(x, dppo_<0x114, 0xf>(-3e38f, x)); x = fmaxf(x, dppo_<0x118, 0xf>(-3e38f, x));
    x = fmaxf(x, dppo_<0x142, 0xa>(-3e38f, x)); x = fmaxf(x, dppo_<0x143, 0xc>(-3e38f, x)); return x;
}
__device__ __forceinline__ float sigmoidf_(float v) { return 1.f / (1.f + __expf(-v)); }
__device__ __forceinline__ float siluf_(float v) { return v * __builtin_amdgcn_rcpf(1.f + __builtin_amdgcn_exp2f(-1.4426950408889634f * v)); }
__device__ __forceinline__ bf16x8 pack8(const float* t) {
    u32x4 w; w.x = pk2(t[0], t[1]); w.y = pk2(t[2], t[3]); w.z = pk2(t[4], t[5]); w.w = pk2(t[6], t[7]); return __builtin_bit_cast(bf16x8, w);
}
typedef int v8i_t __attribute__((ext_vector_type(8)));
typedef int v4i_t __attribute__((ext_vector_type(4)));
constexpr float WSCALE = 32.f, WINV = 1.f / 32.f;
__device__ __forceinline__ unsigned pk4f8(float a, float b, float c, float d) { int w = __builtin_amdgcn_cvt_pk_fp8_f32(a, b, 0, false); w = __builtin_amdgcn_cvt_pk_fp8_f32(c, d, w, true); return (unsigned)w; }
#define MFMA16(a, b, c) __builtin_amdgcn_mfma_f32_16x16x32_bf16((a), (b), (c), 0, 0, 0)

__device__ __forceinline__ void phase_mod(const P& p, char* smem) {
    float* sc = (float*)smem;
    float* red = sc + 9 * 1024;
    for (int i = tid_(); i < 9 * 1024; i += NTHR) { const int s = i >> 10, k = i & 1023; const float v = s < 8 ? p.c[s * 1024 + k] : p.c_ctx[k]; sc[i] = v / (1.f + expf(-v)); }
    __syncthreads();
    const int kg = tid_() >> 6, col = tid_() & 63;
    for (int item = blockIdx.x; item < 192; item += gridDim.x) {
        const int l = item / 96, n0 = (item % 96) * 64;
        float acc[9];
#pragma unroll
        for (int s = 0; s < 9; ++s) acc[s] = 0.f;
        const float* w = p.ada_w + ((size_t)l * 1024 + kg * 128) * 6144 + n0 + col;
        for (int k = 0; k < 128; ++k) {
            const float wv = w[(size_t)k * 6144];
#pragma unroll
            for (int s = 0; s < 9; ++s) acc[s] += sc[s * 1024 + kg * 128 + k] * wv;
        }
#pragma unroll
        for (int s = 0; s < 9; ++s) red[(kg * 9 + s) * 64 + col] = acc[s];
        __syncthreads();
        for (int i = tid_(); i < 576; i += NTHR) {
            const int s = i >> 6, cc = i & 63; float t = 0.f;
#pragma unroll
            for (int k2 = 0; k2 < 8; ++k2) t += red[(k2 * 9 + s) * 64 + cc];
            p.mod[(l * 9 + s) * 6144 + n0 + cc] = t + p.ada_b[l * 6144 + n0 + cc];
        }
        __syncthreads();
    }
    if (blockIdx.x == gridDim.x - 1) {
        for (int i = tid_(); i < 64 * 16; i += NTHR) {
            const int pos = i >> 4, j = i & 15;
            const float inv = exp2f(-(float)j * (13.287712379549449f / 16.0f));
            const float ang = (float)pos * inv;
            float rev = ang * 0.15915494309189535f; rev = rev - floorf(rev);
            p.rope[2 * i] = __builtin_amdgcn_cosf(rev); p.rope[2 * i + 1] = __builtin_amdgcn_sinf(rev);
        }
    }
}

__device__ __forceinline__ void phase_norm0(const P& p) {
    const int lane = tid_() & 63, gw = blockIdx.x * NWAVE + (tid_() >> 6), ngw = gridDim.x * NWAVE;
    const f32x4* g4 = (const f32x4*)(p.norm_g);
    for (int row = gw; row < R; row += ngw) {
        const float* src = row < NL ? p.x + (size_t)row * D : p.ctx + (size_t)(row - NL) * D;
        const int s = row < NL ? (row >> 12) : 8;
        const float* md = p.mod + (size_t)(0 * 9 + s) * 6144;
        f32x4 v[4]; float ss = 0.f;
#pragma unroll
        for (int j = 0; j < 4; ++j) { v[j] = ((const f32x4*)src)[lane + 64 * j]; ss += v[j].x * v[j].x + v[j].y * v[j].y + v[j].z * v[j].z + v[j].w * v[j].w; }
        ss = wave_sum(ss); const float rs = 1.f / sqrtf(ss * (1.f / D) + EPS);
        u32x2* dst = (u32x2*)(p.h + (size_t)row * D);
#pragma unroll
        for (int j = 0; j < 4; ++j) {
            const int ci = lane + 64 * j; const f32x4 gg = g4[ci], sh = ((const f32x4*)md)[ci], scv = ((const f32x4*)(md + 1024))[ci];
            f32x4 o = v[j] * rs * gg * (scv + 1.f) + sh;
            if (QKV_FP8) ((unsigned*)(p.h8 + (size_t)row * D))[ci] = pk4f8(o.x, o.y, o.z, o.w);
            else { u32x2 w; w.x = pk2(o.x, o.y); w.y = pk2(o.z, o.w); dst[ci] = w; }
        }
    }
}

template <bool DUAL, class Epi>
__device__ __forceinline__ void gemm_naive(const bf16_t* A, int lda, size_t strideA, const float* B, const float* B2, int ldb, size_t strideB, int nbatch, int M, int N, int K, const Epi& epi) {
    const int lane = tid_() & 63, g = lane >> 4, c = lane & 15;
    const int gw = blockIdx.x * NWAVE + (tid_() >> 6), ngw = gridDim.x * NWAVE;
    const int tm = M / 64, tn = N / 32; const long per = (long)tm * tn, ntile = per * nbatch;
    for (long t = gw; t < ntile; t += ngw) {
        const int bt = (int)(t / per); const int rem = (int)(t % per); const int mt = rem / tn, nt = rem % tn;
        f32x4 acc[4][2], acc2[4][2];
#pragma unroll
        for (int m = 0; m < 4; ++m)
#pragma unroll
            for (int n = 0; n < 2; ++n) { acc[m][n] = (f32x4){0.f, 0.f, 0.f, 0.f}; acc2[m][n] = (f32x4){0.f, 0.f, 0.f, 0.f}; }
        const bf16_t* Ab = A + (size_t)bt * strideA + (size_t)(mt * 64 + c) * lda + 8 * g;
        const float* Bb = B + (size_t)bt * strideB + (size_t)(8 * g) * ldb + nt * 32 + c;
        const float* Bb2 = DUAL ? B2 + (size_t)bt * strideB + (size_t)(8 * g) * ldb + nt * 32 + c : nullptr;
        for (int k0 = 0; k0 < K; k0 += 32) {
            bf16x8 af[4], bfr[2], bfr2[2];
#pragma unroll
            for (int m = 0; m < 4; ++m) af[m] = *(const bf16x8*)(Ab + (size_t)(m * 16) * lda + k0);
#pragma unroll
            for (int n = 0; n < 2; ++n) {
                float t8[8];
#pragma unroll
                for (int j = 0; j < 8; ++j) t8[j] = Bb[(size_t)(k0 + j) * ldb + n * 16];
                bfr[n] = pack8(t8);
                if (DUAL) {
#pragma unroll
                    for (int j = 0; j < 8; ++j) t8[j] = Bb2[(size_t)(k0 + j) * ldb + n * 16];
                    bfr2[n] = pack8(t8);
                }
            }
#pragma unroll
            for (int m = 0; m < 4; ++m)
#pragma unroll
                for (int n = 0; n < 2; ++n) { acc[m][n] = MFMA16(bfr[n], af[m], acc[m][n]); if (DUAL) acc2[m][n] = MFMA16(bfr2[n], af[m], acc2[m][n]); }
        }
#pragma unroll
        for (int m = 0; m < 4; ++m) epi(bt, mt * 64 + m * 16 + c, nt * 32 + 4 * g, acc[m][0], acc[m][1], acc2[m][0], acc2[m][1]);
    }
}

__device__ __forceinline__ void st4bf(bf16_t* dst, f32x4 v) { u32x2 w; w.x = pk2(v.x, v.y); w.y = pk2(v.z, v.w); *(u32x2*)dst = w; }

struct EpiQKV {
    bf16_t *q, *k, *vT;
    __device__ __forceinline__ void one(int row, int col, f32x4 v) const {
        if (col < 1024) st4bf(q + (size_t)row * D + col, v * 0.125f);
        else if (col < 2048) st4bf(k + (size_t)row * D + (col - 1024), v);
        else { const int d = col - 2048;
#pragma unroll
            for (int i = 0; i < 4; ++i) vT[(size_t)(d + i) * R + row] = f2bf(v[i]); }
    }
    __device__ __forceinline__ void operator()(int, int row, int col, f32x4 v0, f32x4 v1, f32x4, f32x4) const { one(row, col, v0); one(row, col + 16, v1); }
};
struct EpiY {
    bf16_t* y;
    __device__ __forceinline__ void operator()(int, int row, int col, f32x4 v0, f32x4 v1, f32x4, f32x4) const { st4bf(y + (size_t)row * D + col, v0); st4bf(y + (size_t)row * D + col + 16, v1); }
};
struct EpiH {
    bf16_t* H; int cap;
    __device__ __forceinline__ void operator()(int bt, int row, int col, f32x4 a0, f32x4 a1, f32x4 u0, f32x4 u1) const {
        bf16_t* d = H + ((size_t)bt * cap + row) * HID + col;
        f32x4 r0, r1;
#pragma unroll
        for (int i = 0; i < 4; ++i) { r0[i] = siluf_(a0[i]) * u0[i]; r1[i] = siluf_(a1[i]) * u1[i]; }
        st4bf(d, r0); st4bf(d + 16, r1);
    }
};
struct EpiYM {
    bf16_t* Y; const float* gatev; int cap;
    __device__ __forceinline__ void operator()(int bt, int row, int col, f32x4 v0, f32x4 v1, f32x4, f32x4) const {
        const float gv = gatev[bt * CAP0 + row]; bf16_t* d = Y + ((size_t)bt * cap + row) * D + col;
        st4bf(d, v0 * gv); st4bf(d + 16, v1 * gv);
    }
};
struct EpiMLIN {
    bf16_t *qm, *km, *vm, *om; float* gates; const float* rope; const float* bgate;
    __device__ __forceinline__ void operator()(int, int row, int col, f32x4 v0, f32x4 v1, f32x4, f32x4) const {
        if (col < 1024) {
            const bool isk = col >= 512; const int cc = isk ? col - 512 : col;
            if (row < NL) {
                const int t = row & 4095; const int hd = cc & 63; const int pos = (hd < 32) ? (t >> 6) : (t & 63); const int j0 = hd & 15;
                const float* rp = rope + (pos * 16 + j0) * 2;
#pragma unroll
                for (int i = 0; i < 4; ++i) { const float cs = rp[2 * i], sn = rp[2 * i + 1]; const float a = v0[i], b = v1[i]; v0[i] = a * cs - b * sn; v1[i] = a * sn + b * cs; }
            }
            if (isk) { v0 = v0 * 0.125f; v1 = v1 * 0.125f; }
            bf16_t* d = (isk ? km : qm) + (size_t)row * 512 + cc; st4bf(d, v0); st4bf(d + 16, v1);
        } else if (col < 2048) { bf16_t* d = vm + (size_t)row * D + (col - 1024); st4bf(d, v0); st4bf(d + 16, v1); }
        else if (col < 3072) { bf16_t* d = om + (size_t)row * D + (col - 2048); st4bf(d, v0); st4bf(d + 16, v1); }
        else { const int gc = col - 3072;
            f32x4 o0, o1;
#pragma unroll
            for (int i = 0; i < 4; ++i) { o0[i] = v0[i] + bgate[gc + i]; const float f = v1[i] + bgate[gc + 16 + i]; o1[i] = fminf(f, 0.f) - log1pf(__expf(-fabsf(f))); }
            *(f32x4*)(gates + (size_t)row * 32 + gc) = o0; *(f32x4*)(gates + (size_t)row * 32 + gc + 16) = o1; }
    }
};


namespace pg8 {
#define PG8_LAS __attribute__((address_space(3)))
constexpr int BM = 256, BK = 64, HALF = 128, HTB = HALF * BK * 2, STAGE_BYTES = 8 * HTB, NXCD = 8, WGM = 8;
__host__ __device__ __forceinline__ int lds_byte(int r, int c) { const int st = (r >> 4) * 2 + (c >> 5), rr = r & 15, cc = c & 31, ob = rr * 64 + cc * 2; return st * 1024 + (ob ^ (((ob >> 9) & 1) << 5)); }
__host__ __device__ __forceinline__ void stage_rc(int b, int& R_, int& C_) { const int st = b / 1024, sb = b % 1024, swz = sb ^ (((sb >> 9) & 1) << 5); R_ = (st >> 1) * 16 + swz / 64; C_ = (st & 1) * 32 + (swz % 64) / 2; }
__host__ __device__ __forceinline__ int perm32(int rho) { const int n = rho >> 4, i = rho & 15; return 8 * (i >> 2) + 4 * n + (i & 3); }
struct Unit { const char* a; const char* b; const int* lst; int pm, pn, job; };
__device__ __forceinline__ void tile_of(int L, int nM, int nN, int& pm, int& pn) {
    const int nwg = nM * nN; int wgid = L; { const int q = nwg / NXCD, r = nwg % NXCD, xcd = wgid % NXCD, off = wgid / NXCD; wgid = (xcd < r ? xcd * (q + 1) : r * (q + 1) + (xcd - r) * q) + off; }
    const int nig = WGM * nN, gid = wgid / nig, fm = gid * WGM, gsz = (nM - fm) < WGM ? (nM - fm) : WGM;
    pm = fm + ((wgid % nig) % gsz); pn = (wgid % nig) / gsz;
}
template <bool FP8, bool GATH, class Epi, class Sched>
__device__ __forceinline__ void gemm_phase(PG8_LAS unsigned char* lds, const int K, const size_t bhs  , const Sched& S, const Epi& E) {
    const int tid = tid_(), wid = __builtin_amdgcn_readfirstlane(tid >> 6), lane = tid & 63, wr = wid >> 2, wc = wid & 3, fr = lane & 15, fq = lane >> 4;
    const int nt = K / BK;
    unsigned voffA[2], voffB[2]; int arow[2]; unsigned acol[2];
#pragma unroll
    for (int i = 0; i < 2; ++i) { int R_, C_; stage_rc(tid * 16 + i * 8192, R_, C_); const int Rb = Epi::PERM ? ((R_ & ~31) + perm32(R_ & 31)) : R_;
        voffA[i] = (unsigned)(R_ * K + C_) * 2u; voffB[i] = (unsigned)(Rb * K + C_) * 2u; arow[i] = R_; acol[i] = (unsigned)C_ * 2u; }
    unsigned vA[2][2], vAn[2][2];
#define PG8_LOADOFF(dst, u) do { _Pragma("unroll") for (int h_ = 0; h_ < 2; ++h_) _Pragma("unroll") for (int i_ = 0; i_ < 2; ++i_) dst[h_][i_] = (unsigned)(u).lst[h_ * HALF + arow[i_]] * (unsigned)(K * 2) + acol[i_]; } while (0)
#define PG8_STAGE_A(bufoff, aptr, h, nx) do { if constexpr (GATH) { unsigned vv_[2]; vv_[0] = (nx) ? vAn[h][0] : vA[h][0]; vv_[1] = (nx) ? vAn[h][1] : vA[h][1]; PG8_STAGE(bufoff, aptr, vv_); } \
        else { PG8_STAGE(bufoff, (aptr) + (h) * ahs, voffA); } } while (0)
    const size_t kstep = (size_t)(BK * 2);
    const size_t ahs = (size_t)HALF * K * 2;
    const unsigned ldsw = (unsigned)wid * 1024u;
    const int aoff = lds_byte(wr * 64 + fr, fq * 8), boff = lds_byte(wc * 32 + fr, fq * 8);
#define PG8_SA(b, h) (((b) * 2 + (h)) * HTB)
#define PG8_SB(b, h) ((4 + (b) * 2 + (h)) * HTB)
#define PG8_STAGE(bufoff, gbase, voff) do { _Pragma("unroll") for (int _i = 0; _i < 2; ++_i) \
        __builtin_amdgcn_global_load_lds((const unsigned*)((const char*)(gbase) + (voff)[_i]), (PG8_LAS unsigned*)(lds + (bufoff) + ldsw + _i * 8192), 16, 0, 0); } while (0)
#define PG8_LDA(dst, b, h) do { _Pragma("unroll") for (int m = 0; m < 4; ++m) _Pragma("unroll") for (int k = 0; k < 2; ++k) dst[m][k] = *(const PG8_LAS bf16x8*)(lds + PG8_SA(b, h) + aoff + m * 2048 + k * 1024); } while (0)
#define PG8_LDB(dst, b, h) do { _Pragma("unroll") for (int n = 0; n < 2; ++n) _Pragma("unroll") for (int k = 0; k < 2; ++k) dst[n][k] = *(const PG8_LAS bf16x8*)(lds + PG8_SB(b, h) + boff + n * 2048 + k * 1024); } while (0)
#define PG8_CAT(x, y) __builtin_shufflevector(__builtin_bit_cast(v4i_t, x), __builtin_bit_cast(v4i_t, y), 0, 1, 2, 3, 4, 5, 6, 7)
#define PG8_MMA(ai, bj, At, Bt) do { __builtin_amdgcn_s_setprio(1); if constexpr (FP8) { _Pragma("unroll") for (int m = 0; m < 4; ++m) _Pragma("unroll") for (int n = 0; n < 2; ++n) \
        { const v8i_t a8_ = PG8_CAT(Bt[n][0], Bt[n][1]), b8_ = PG8_CAT(At[m][0], At[m][1]); asm volatile("v_mfma_scale_f32_16x16x128_f8f6f4 %0, %1, %2, %0, %3, %3 op_sel_hi:[0,0,0]" : "+v"(acc[ai][bj][m][n]) : "v"(a8_), "v"(b8_), "v"(sc127)); } } \
        else { _Pragma("unroll") for (int m = 0; m < 4; ++m) _Pragma("unroll") for (int n = 0; n < 2; ++n) _Pragma("unroll") for (int k = 0; k < 2; ++k) \
        acc[ai][bj][m][n] = __builtin_amdgcn_mfma_f32_16x16x32_bf16(Bt[n][k], At[m][k], acc[ai][bj][m][n], 0, 0, 0); } __builtin_amdgcn_s_setprio(0); } while (0)
#define PG8_WAIT_V(n) asm volatile("s_waitcnt vmcnt(" #n ")" ::: "memory")
#define PG8_WAIT_L(n) asm volatile("s_waitcnt lgkmcnt(" #n ")" ::: "memory")
#define PG8_BAR __builtin_amdgcn_s_barrier()
#define PG8_SCHED __builtin_amdgcn_sched_barrier(0)
    Unit cur, nxt; int ui = 0;
    if (!S.next(0, cur)) return;
    int sc127 = 0x7f7f7f7f; asm volatile("" : "+v"(sc127));
    f32x4 acc[2][2][4][2];
#pragma unroll
    for (int a = 0; a < 2; ++a)
#pragma unroll
        for (int b = 0; b < 2; ++b)
#pragma unroll
            for (int m = 0; m < 4; ++m)
#pragma unroll
                for (int n = 0; n < 2; ++n) acc[a][b][m][n] = (f32x4){0.f, 0.f, 0.f, 0.f};
    bf16x8 At[4][2], B0[2][2], B1[2][2];
    const char* cA = cur.a; const char* cB = cur.b;
    if constexpr (GATH) { PG8_LOADOFF(vA, cur); PG8_LOADOFF(vAn, cur); }
    PG8_STAGE(PG8_SB(0, 0), cB, voffB); PG8_STAGE(PG8_SB(0, 1), cB + bhs, voffB); PG8_STAGE_A(PG8_SA(0, 0), cA, 0, false); PG8_STAGE_A(PG8_SA(0, 1), cA, 1, false);
    if (wr == 1) PG8_BAR;
    PG8_WAIT_V(2); PG8_BAR;
    PG8_STAGE(PG8_SB(1, 0), cB + kstep, voffB); PG8_STAGE_A(PG8_SA(1, 0), cA + kstep, 0, false); PG8_STAGE(PG8_SB(1, 1), cB + bhs + kstep, voffB);
    PG8_WAIT_V(6); PG8_BAR;
    for (;;) {
        const bool has_next = S.next(ui + 1, nxt);
        const char* nA = has_next ? nxt.a : cA; const char* nB = has_next ? nxt.b : cB;
        if constexpr (GATH) { if (has_next) { PG8_LOADOFF(vAn, nxt); } }
        for (int t = 0; t < nt; t += 2) {
            const bool last = (t == nt - 2);
            const char* a1 = cA + (size_t)(t + 1) * kstep;
            const char* a2 = last ? nA : cA + (size_t)(t + 2) * kstep; const char* b2 = last ? nB : cB + (size_t)(t + 2) * kstep;
            const char* a3 = a2 + kstep; const char* b3 = b2 + kstep; const bool nx = last && has_next;
            PG8_LDB(B0, 0, 0); PG8_LDB(B1, 0, 1); PG8_SCHED; PG8_LDA(At, 0, 0); PG8_STAGE_A(PG8_SA(1, 1), a1, 1, false);
            PG8_WAIT_V(8); PG8_WAIT_L(0); PG8_BAR; PG8_MMA(0, 0, At, B0); PG8_MMA(0, 1, At, B1); PG8_BAR; PG8_SCHED;
            PG8_LDA(At, 0, 1); PG8_STAGE(PG8_SB(0, 0), b2, voffB); PG8_STAGE(PG8_SB(0, 1), b2 + bhs, voffB); PG8_STAGE_A(PG8_SA(0, 0), a2, 0, nx);
            PG8_WAIT_V(8); PG8_WAIT_L(0); PG8_BAR; PG8_MMA(1, 0, At, B0); PG8_MMA(1, 1, At, B1); PG8_BAR; PG8_SCHED;
            PG8_LDB(B0, 1, 0); PG8_LDB(B1, 1, 1); PG8_SCHED; PG8_LDA(At, 1, 0); PG8_STAGE_A(PG8_SA(0, 1), a2, 1, nx);
            PG8_WAIT_V(8); PG8_WAIT_L(0); PG8_BAR; PG8_MMA(0, 0, At, B0); PG8_MMA(0, 1, At, B1); PG8_BAR; PG8_SCHED;
            PG8_LDA(At, 1, 1); PG8_STAGE(PG8_SB(1, 0), b3, voffB); PG8_STAGE(PG8_SB(1, 1), b3 + bhs, voffB); PG8_STAGE_A(PG8_SA(1, 0), a3, 0, nx);
            PG8_WAIT_V(8); PG8_WAIT_L(0); PG8_BAR; PG8_MMA(1, 0, At, B0); PG8_MMA(1, 1, At, B1); PG8_BAR; PG8_SCHED;
        }
        if (wr == 0) PG8_BAR;
        if constexpr (FP8) { asm volatile("s_nop 15\n\ts_nop 15" ::: "memory"); }
        E(acc, cur, wr, wc, fr, fq);
        if (!has_next) break;
#pragma unroll
        for (int a = 0; a < 2; ++a)
#pragma unroll
            for (int b = 0; b < 2; ++b)
#pragma unroll
                for (int m = 0; m < 4; ++m)
#pragma unroll
                    for (int n = 0; n < 2; ++n) acc[a][b][m][n] = (f32x4){0.f, 0.f, 0.f, 0.f};
        cur = nxt; cA = nA; cB = nB; ++ui;
        if constexpr (GATH) { _Pragma("unroll") for (int h_ = 0; h_ < 2; ++h_) _Pragma("unroll") for (int i_ = 0; i_ < 2; ++i_) vA[h_][i_] = vAn[h_][i_]; }
        if (wr == 1) PG8_BAR;
    }
    PG8_WAIT_V(0);
    PG8_BAR;
#undef PG8_SA
#undef PG8_SB
#undef PG8_STAGE
#undef PG8_STAGE_A
#undef PG8_LOADOFF
#undef PG8_LDA
#undef PG8_LDB
#undef PG8_MMA
#undef PG8_CAT
#undef PG8_WAIT_V
#undef PG8_WAIT_L
#undef PG8_BAR
#undef PG8_SCHED
}
}

typedef float accT[2][2][4][2][4];
__device__ __forceinline__ void st8bf(bf16_t* dst, f32x4 a, f32x4 b) { u32x4 w; w.x = pk2(a.x, a.y); w.y = pk2(a.z, a.w); w.z = pk2(b.x, b.y); w.w = pk2(b.z, b.w); *(u32x4*)dst = w; }

struct SchedQKV {
    const char *h, *W; int es, G, c;
    __device__ __forceinline__ bool next(int i, pg8::Unit& u) const {
        const int L = i * G + c; if (L >= 1088 + 544) return false;
        if (L < 1088) { pg8::tile_of(L, 136, 8, u.pm, u.pn); u.job = 0; u.a = h + (size_t)u.pm * 256 * D * es; u.b = W + (size_t)u.pn * 256 * D * es; }
        else { pg8::tile_of(L - 1088, 4, 136, u.pm, u.pn); u.job = 1; u.a = W + (size_t)(2048 + u.pm * 256) * D * es; u.b = h + (size_t)u.pn * 256 * D * es; }
        return true;
    }
};
struct SchedPlain {
    const char *A, *Bt; int nM, nN, KB  , G, c;
    __device__ __forceinline__ bool next(int i, pg8::Unit& u) const {
        const int L = i * G + c; if (L >= nM * nN) return false;
        pg8::tile_of(L, nM, nN, u.pm, u.pn); u.job = 0; u.a = A + (size_t)u.pm * 256 * KB; u.b = Bt + (size_t)u.pn * 256 * KB; return true;
    }
};
struct SchedMoeUp {
    const fp8_t *Xg, *Wgu; int tmE, G, c;
    __device__ __forceinline__ bool next(int i, pg8::Unit& u) const {
        const int L = i * G + c; if (L >= NE * tmE * 16) return false;
        pg8::tile_of(L, NE * tmE, 16, u.pm, u.pn); const int e = u.pm / tmE; u.job = e;
        u.a = (const char*)(Xg + (size_t)u.pm * 256 * D); u.b = (const char*)(Wgu + ((size_t)e * 4096 + u.pn * 128) * D); return true;
    }
};
struct SchedMoeUpG {
    const fp8_t *h28, *Wgu; const int* list; int tmE, G, c;
    __device__ __forceinline__ bool next(int i, pg8::Unit& u) const {
        const int L = i * G + c; if (L >= NE * tmE * 16) return false;
        pg8::tile_of(L, NE * tmE, 16, u.pm, u.pn); const int e = u.pm / tmE; u.job = e;
        u.a = (const char*)h28; u.lst = list + e * CAP0 + (u.pm - e * tmE) * 256; u.b = (const char*)(Wgu + ((size_t)e * 4096 + u.pn * 128) * D); return true;
    }
};
struct SchedMoeDown {
    const fp8_t *Hh, *Wd; int tmE, G, c;
    __device__ __forceinline__ bool next(int i, pg8::Unit& u) const {
        const int L = i * G + c; if (L >= NE * tmE * 4) return false;
        pg8::tile_of(L, NE * tmE, 4, u.pm, u.pn); const int e = u.pm / tmE; u.job = e;
        u.a = (const char*)(Hh + (size_t)u.pm * 256 * HID); u.b = (const char*)(Wd + ((size_t)e * 1024 + u.pn * 256) * HID); return true;
    }
};
struct EpiQKV2 { static constexpr bool PERM = true;
    bf16_t *q, *k, *vT; float osc;
    __device__ __forceinline__ void operator()(const f32x4 (&acc)[2][2][4][2], const pg8::Unit& u, int wr, int wc, int fr, int fq) const {
        const int row0 = u.pm * 256 + wr * 64 + fr, col0 = u.pn * 256 + wc * 32 + 8 * fq;
        bf16_t* base; size_t ld; float sc = 1.f;
        if (u.job == 0) { ld = D; if (col0 < 1024) { base = q + col0; sc = 0.125f * 1.4426950408889634f; } else base = k + (col0 - 1024); }
        else { ld = R; base = vT + col0; }
#pragma unroll
        for (int ai = 0; ai < 2; ++ai)
#pragma unroll
            for (int m = 0; m < 4; ++m) { bf16_t* rp = base + (size_t)(row0 + ai * 128 + m * 16) * ld;
#pragma unroll
                for (int bj = 0; bj < 2; ++bj) st8bf(rp + bj * 128, acc[ai][bj][m][0] * (sc * osc), acc[ai][bj][m][1] * (sc * osc)); }
    }
};
struct EpiYb { static constexpr bool PERM = true;
    bf16_t* y;
    __device__ __forceinline__ void operator()(const f32x4 (&acc)[2][2][4][2], const pg8::Unit& u, int wr, int wc, int fr, int fq) const {
        const int row0 = u.pm * 256 + wr * 64 + fr, col0 = u.pn * 256 + wc * 32 + 8 * fq;
#pragma unroll
        for (int ai = 0; ai < 2; ++ai)
#pragma unroll
            for (int m = 0; m < 4; ++m) { bf16_t* rp = y + (size_t)(row0 + ai * 128 + m * 16) * D + col0;
#pragma unroll
                for (int bj = 0; bj < 2; ++bj) st8bf(rp + bj * 128, acc[ai][bj][m][0], acc[ai][bj][m][1]); }
    }
};
struct EpiHb { static constexpr bool PERM = true;
    fp8_t* H;
    __device__ __forceinline__ void operator()(const f32x4 (&acc)[2][2][4][2], const pg8::Unit& u, int wr, int wc, int fr, int fq) const {
        const int row0 = u.pm * 256 + wr * 64 + fr, col0 = u.pn * 128 + wc * 32 + 8 * fq;
#pragma unroll
        for (int ai = 0; ai < 2; ++ai)
#pragma unroll
            for (int m = 0; m < 4; ++m) { f32x4 r0, r1;
#pragma unroll
                for (int i = 0; i < 4; ++i) { r0[i] = siluf_(acc[ai][0][m][0][i] * WINV) * (acc[ai][1][m][0][i] * WINV); r1[i] = siluf_(acc[ai][0][m][1][i] * WINV) * (acc[ai][1][m][1][i] * WINV); }
                u32x2 w; w.x = pk4f8(r0.x, r0.y, r0.z, r0.w); w.y = pk4f8(r1.x, r1.y, r1.z, r1.w); *(u32x2*)(H + (size_t)(row0 + ai * 128 + m * 16) * HID + col0) = w; }
    }
};
struct EpiYMb { static constexpr bool PERM = true;
    bf16_t* Y; const float* gatev; int tmE;
    __device__ __forceinline__ void operator()(const f32x4 (&acc)[2][2][4][2], const pg8::Unit& u, int wr, int wc, int fr, int fq) const {
        const int row0 = u.pm * 256 + wr * 64 + fr, col0 = u.pn * 256 + wc * 32 + 8 * fq; const int e = u.job, rl0 = row0 - e * tmE * 256;
#pragma unroll
        for (int ai = 0; ai < 2; ++ai)
#pragma unroll
            for (int m = 0; m < 4; ++m) { const float gv = gatev[e * CAP0 + rl0 + ai * 128 + m * 16] * WINV; bf16_t* rp = Y + (size_t)(row0 + ai * 128 + m * 16) * D + col0;
#pragma unroll
                for (int bj = 0; bj < 2; ++bj) st8bf(rp + bj * 128, acc[ai][bj][m][0] * gv, acc[ai][bj][m][1] * gv); }
    }
};
struct EpiMLINb { static constexpr bool PERM = false;
    bf16_t *qm, *km, *vm, *om; const float* rope; float* gates; const float* bgate; float osc;
    __device__ __forceinline__ void operator()(const f32x4 (&acc)[2][2][4][2], const pg8::Unit& u, int wr, int wc, int fr, int fq) const {
        const int row0 = u.pm * 256 + wr * 64 + fr;
        if (u.pn == 12) {
            if (wc == 0) { const int gc = 4 * fq; const f32x4 bi = *(const f32x4*)(bgate + gc), bf = *(const f32x4*)(bgate + 16 + gc);
#pragma unroll
                for (int ai = 0; ai < 2; ++ai)
#pragma unroll
                    for (int m = 0; m < 4; ++m) { const int row = row0 + ai * 128 + m * 16; const f32x4 o0 = acc[ai][0][m][0] * osc + bi; const f32x4 fv = acc[ai][0][m][1] * osc + bf; f32x4 o1;
#pragma unroll
                        for (int i = 0; i < 4; ++i) o1[i] = fminf(fv[i], 0.f) - log1pf(__expf(-fabsf(fv[i])));
                        *(f32x4*)(gates + (size_t)row * 32 + gc) = o0; *(f32x4*)(gates + (size_t)row * 32 + gc + 16) = o1; } }
        } else if (u.pn < 4) {
            const bool isk = u.pn >= 2; bf16_t* dst = isk ? km : qm; const float sc = (isk ? 0.125f : 1.f) * osc;
            const bool lat = (u.pm * 256) < NL;
#pragma unroll
            for (int bj = 0; bj < 2; ++bj) {
                const int cc = (u.pn & 1) * 256 + bj * 128 + wc * 32 + 4 * fq; const int hd = cc & 63;
#pragma unroll
                for (int ai = 0; ai < 2; ++ai)
#pragma unroll
                    for (int m = 0; m < 4; ++m) { const int row = row0 + ai * 128 + m * 16; f32x4 v0 = acc[ai][bj][m][0], v1 = acc[ai][bj][m][1];
                        if (lat) { const int t = row & 4095; const int pos = (hd < 32) ? (t >> 6) : (t & 63); const f32x4* rp = (const f32x4*)(rope + (pos * 16 + (hd & 15)) * 2);
                            const f32x4 r01 = rp[0], r23 = rp[1];
                            const float c0 = r01.x, s0 = r01.y, c1 = r01.z, s1 = r01.w, c2 = r23.x, s2 = r23.y, c3 = r23.z, s3 = r23.w;
                            f32x4 a = v0, b = v1;
                            v0 = (f32x4){a.x * c0 - b.x * s0, a.y * c1 - b.y * s1, a.z * c2 - b.z * s2, a.w * c3 - b.w * s3};
                            v1 = (f32x4){a.x * s0 + b.x * c0, a.y * s1 + b.y * c1, a.z * s2 + b.z * c2, a.w * s3 + b.w * c3}; }
                        bf16_t* d = dst + (size_t)row * 512 + cc; st4bf(d, v0 * sc); st4bf(d + 16, v1 * sc);
                        asm volatile("" ::: "memory"); }
            }
        } else {
            bf16_t* dst = (u.pn < 8 ? vm : om) + ((u.pn & 3) * 256) + wc * 32 + 4 * fq;
#pragma unroll
            for (int bj = 0; bj < 2; ++bj)
#pragma unroll
                for (int ai = 0; ai < 2; ++ai)
#pragma unroll
                    for (int m = 0; m < 4; ++m) { bf16_t* d = dst + (size_t)(row0 + ai * 128 + m * 16) * D + bj * 128; st4bf(d, acc[ai][bj][m][0] * osc); st4bf(d + 16, acc[ai][bj][m][1] * osc); }
        }
    }
};
struct EpiGates {
    float* gates; const float* bgate;
    __device__ __forceinline__ void operator()(int, int row, int gc, f32x4 v0, f32x4 v1, f32x4, f32x4) const {
        f32x4 o0, o1;
#pragma unroll
        for (int i = 0; i < 4; ++i) { o0[i] = v0[i] + bgate[gc + i]; const float f = v1[i] + bgate[gc + 16 + i]; o1[i] = fminf(f, 0.f) - log1pf(__expf(-fabsf(f))); }
        *(f32x4*)(gates + (size_t)row * 32 + gc) = o0; *(f32x4*)(gates + (size_t)row * 32 + gc + 16) = o1;
    }
};

__device__ __forceinline__ void transpose_item(const float* W, int K, int N, bf16_t* WT, int row_off, float* scr, int item, int lane) {
    const int nblk = N / 32, kb = item / nblk, nb = item % nblk, k0 = 64 * kb, n0 = 32 * nb;
#pragma unroll 8
    for (int i = 0; i < 32; ++i) { const int kk = 2 * i + (lane >> 5); scr[kk * 33 + (lane & 31)] = W[(size_t)(k0 + kk) * N + n0 + (lane & 31)]; }
    asm volatile("s_waitcnt lgkmcnt(0)" ::: "memory");
    const int c8 = lane & 7;
#pragma unroll
    for (int j = 0; j < 4; ++j) { const int n = (lane >> 3) + 8 * j; const float* s2 = scr + (8 * c8) * 33 + n;
        u32x4 o; o.x = pk2(s2[0 * 33], s2[1 * 33]); o.y = pk2(s2[2 * 33], s2[3 * 33]); o.z = pk2(s2[4 * 33], s2[5 * 33]); o.w = pk2(s2[6 * 33], s2[7 * 33]);
        *(u32x4*)(WT + (size_t)(row_off + n0 + n) * K + k0 + 8 * c8) = o; }
    asm volatile("s_waitcnt lgkmcnt(0)" ::: "memory");
}
__device__ __forceinline__ void transpose_item8(const float* W, int K, int N, fp8_t* WT, int row_off, float* scr, int item, int lane) {
    const int nblk = N / 32, kb = item / nblk, nb = item % nblk, k0 = 64 * kb, n0 = 32 * nb;
#pragma unroll 8
    for (int i = 0; i < 32; ++i) { const int kk = 2 * i + (lane >> 5); scr[kk * 33 + (lane & 31)] = W[(size_t)(k0 + kk) * N + n0 + (lane & 31)]; }
    asm volatile("s_waitcnt lgkmcnt(0)" ::: "memory");
    const int c8 = lane & 7;
#pragma unroll
    for (int j = 0; j < 4; ++j) { const int n = (lane >> 3) + 8 * j; const float* s2 = scr + (8 * c8) * 33 + n;
        u32x2 o; o.x = pk4f8(s2[0 * 33] * WSCALE, s2[1 * 33] * WSCALE, s2[2 * 33] * WSCALE, s2[3 * 33] * WSCALE); o.y = pk4f8(s2[4 * 33] * WSCALE, s2[5 * 33] * WSCALE, s2[6 * 33] * WSCALE, s2[7 * 33] * WSCALE);
        *(u32x2*)(WT + (size_t)(row_off + n0 + n) * K + k0 + 8 * c8) = o; }
    asm volatile("s_waitcnt lgkmcnt(0)" ::: "memory");
}
constexpr int CV_IPM = 512, CV_IPE = 3 * CV_IPM, CV_NITL = NE * CV_IPE, CV_NIT = 2 * CV_NITL;
constexpr int CV_CNT_WORD = 15360;
__device__ __forceinline__ int cv_pull(unsigned* cnt, int lane) { unsigned v = 0; if (lane == 0) v = __hip_atomic_fetch_add(cnt, 1u, __ATOMIC_RELAXED, __HIP_MEMORY_SCOPE_AGENT); return (int)__builtin_amdgcn_readfirstlane(v); }
__device__ __forceinline__ void convert_moe_fill(const P& p, float* scr, int base, int limit, int first_cu) {
    const int lane = tid_() & 63; if (gridDim.x != 256) first_cu = 0;
    if ((int)blockIdx.x < first_cu) return;
    const int nw = ((int)gridDim.x - first_cu) * NWAVE; int idx = base + ((int)blockIdx.x - first_cu) * NWAVE + (tid_() >> 6);
    const int lr = lane >> 4, lc = lane & 15;
#define CV_DECODE(idx_, W_, N_, K_, WT_, k0_, n0_) do { const int l_ = (idx_) / CV_NITL, it_ = (idx_) % CV_NITL; const int e_ = it_ / CV_IPE, r_ = it_ % CV_IPE, mat_ = r_ / CV_IPM, q_ = r_ % CV_IPM; \
        if (mat_ == 0) { W_ = p.moe_wg + ((size_t)l_ * NE + e_) * D * HID; N_ = HID; K_ = D; WT_ = p.Wgu8 + ((size_t)l_ * NE + e_) * 4096 * D; } \
        else if (mat_ == 1) { W_ = p.moe_wu + ((size_t)l_ * NE + e_) * D * HID; N_ = HID; K_ = D; WT_ = p.Wgu8 + (((size_t)l_ * NE + e_) * 4096 + 2048) * D; } \
        else { W_ = p.moe_wd + ((size_t)l_ * NE + e_) * HID * D; N_ = D; K_ = HID; WT_ = p.Wd8 + ((size_t)l_ * NE + e_) * 1024 * HID; } \
        const int nb_ = N_ / 64; k0_ = 64 * (q_ / nb_); n0_ = 64 * (q_ % nb_); } while (0)
    f32x4 v[16];
    const float* W; int N, K, k0, n0; fp8_t* WT;
    if (idx < limit) { CV_DECODE(idx, W, N, K, WT, k0, n0);
#pragma unroll
        for (int i = 0; i < 16; ++i) v[i] = *(const f32x4*)(W + (size_t)(k0 + 4 * i + lr) * N + n0 + 4 * lc); }
    while (idx < limit) {
#pragma unroll
        for (int i = 0; i < 16; ++i) { float* d = scr + (4 * i + lr) * 65 + 4 * lc; d[0] = v[i].x; d[1] = v[i].y; d[2] = v[i].z; d[3] = v[i].w; }
        fp8_t* WTc = WT; const int Kc = K, k0c = k0, n0c = n0;
        idx += nw;
        if (idx < limit) { CV_DECODE(idx, W, N, K, WT, k0, n0);
#pragma unroll
            for (int i = 0; i < 16; ++i) v[i] = *(const f32x4*)(W + (size_t)(k0 + 4 * i + lr) * N + n0 + 4 * lc); }
#pragma unroll
        for (int pp = 0; pp < 4; ++pp) { const int n = 16 * pp + (lane >> 2), c = lane & 3; const float* s2 = scr + (16 * c) * 65 + n;
            u32x4 o; o.x = pk4f8(s2[0 * 65] * WSCALE, s2[1 * 65] * WSCALE, s2[2 * 65] * WSCALE, s2[3 * 65] * WSCALE); o.y = pk4f8(s2[4 * 65] * WSCALE, s2[5 * 65] * WSCALE, s2[6 * 65] * WSCALE, s2[7 * 65] * WSCALE);
            o.z = pk4f8(s2[8 * 65] * WSCALE, s2[9 * 65] * WSCALE, s2[10 * 65] * WSCALE, s2[11 * 65] * WSCALE); o.w = pk4f8(s2[12 * 65] * WSCALE, s2[13 * 65] * WSCALE, s2[14 * 65] * WSCALE, s2[15 * 65] * WSCALE);
            *(u32x4*)(WTc + (size_t)(n0c + n) * Kc + k0c + 16 * c) = o; }
        asm volatile("s_waitcnt lgkmcnt(0)" ::: "memory");
    }
#undef CV_DECODE
}
__device__ __forceinline__ void convert_small_weights(const P& p, char* smem) {
    const int lane = tid_() & 63, wid = tid_() >> 6, gw = blockIdx.x * NWAVE + wid, ngw = gridDim.x * NWAVE;
    float* scr = (float*)smem + wid * (64 * 33);
    constexpr int I1 = 16 * 96, I2 = 16 * 32, I3 = 16 * 97, I4 = 16 * 32;
    for (int it = gw; it < I1 + I2 + I3 + I4; it += ngw) {
        int r = it;
        if (r < I1) { if (QKV_FP8) transpose_item8(p.na_wqkv, D, 3 * D, p.Wqkv8, 0, scr, r, lane); else transpose_item(p.na_wqkv, D, 3 * D, p.Wqkv_t, 0, scr, r, lane); continue; } r -= I1;
        if (r < I2) { transpose_item(p.na_wout, D, D, p.Wo0_t, 0, scr, r, lane); continue; } r -= I2;
        if (r < I3) { if (MLIN_FP8) transpose_item8(p.ml_win, D, MLW, p.Win8, 0, scr, r, lane); else transpose_item(p.ml_win, D, MLW, p.Win_t, 0, scr, r, lane); continue; } r -= I3;
        transpose_item(p.ml_wout, D, D, p.Wo1_t, 0, scr, r, lane);
    }
}

__host__ __device__ constexpr unsigned long long attn_mask(int hf, int jb, int j) {
    unsigned long long m = 0ull;
    for (int l = 0; l < 64; ++l) { const int g = l >> 4, c = l & 15, qc = 16 * jb + c; int wc0 = qc - 8; wc0 = wc0 < 0 ? 0 : (wc0 > 48 ? 48 : wc0); const int kc = hf * 32 + 8 * g + j;
        if (kc >= wc0 && kc < wc0 + 16) m |= (1ull << l); }
    return m;
}
__device__ __forceinline__ float amax2(float a, float b) { float r; asm("v_max_f32_e32 %0, %1, %2" : "=v"(r) : "v"(a), "v"(b)); return r; }
__device__ __forceinline__ float amax3(float a, float b, float c) { float r; asm("v_max3_f32 %0, %1, %2, %3" : "=v"(r) : "v"(a), "v"(b), "v"(c)); return r; }
__device__ __forceinline__ float sel_mask(float neg, float val, unsigned long long m) { float r; asm("v_cndmask_b32_e64 %0, %1, %2, %3" : "=v"(r) : "v"(neg), "v"(val), "s"(m)); return r; }
__device__ __forceinline__ float x16_amax(float v) { auto r = __builtin_amdgcn_permlane16_swap(__float_as_uint(v), __float_as_uint(v), false, false); return amax2(__uint_as_float(r[0]), __uint_as_float(r[1])); }
__device__ __forceinline__ float x32_amax(float v) { auto r = __builtin_amdgcn_permlane32_swap(__float_as_uint(v), __float_as_uint(v), false, false); return amax2(__uint_as_float(r[0]), __uint_as_float(r[1])); }

#define ATT_THR 16.f
#define ATT_SOFTMAX_PV(jb, vf, force) do { \
        float mx = __builtin_fmaxf(__builtin_fmaxf(sv[0], sv[1]), sv[2]); mx = __builtin_fmaxf(__builtin_fmaxf(mx, sv[3]), sv[4]); mx = __builtin_fmaxf(__builtin_fmaxf(mx, sv[5]), sv[6]); mx = __builtin_fmaxf(mx, sv[7]); \
        if ((force) || __any(mx > ATT_THR)) { mx = x16_amax(mx); mx = x32_amax(mx); const float dl = (force) ? mx : fmaxf(mx, 0.f); const float alpha = __builtin_amdgcn_exp2f(-dl);        \
            const float nm = negm[jb][0] - dl; negm[jb] = (f32x4){nm, nm, nm, nm}; \
            _Pragma("unroll") for (int j = 0; j < 8; ++j) sv[j] -= dl; \
            OL[jb] = OL[jb] * alpha; _Pragma("unroll") for (int dt = 0; dt < 4; ++dt) O[jb][dt] = O[jb][dt] * alpha; } \
        _Pragma("unroll") for (int j = 0; j < 8; ++j) sv[j] = __builtin_amdgcn_exp2f(sv[j]); \
        const bf16x8 pf = pack8(sv); \
        _Pragma("unroll") for (int dt = 0; dt < 4; ++dt) O[jb][dt] = MFMA16(vf[dt], pf, O[jb][dt]); \
        OL[jb] = MFMA16(onesf, pf, OL[jb]); } while (0)
#define ATT_QK(i_, kf) do { f32x4 s0, s1;        \
        s0 = MFMA16(kf[0][0], qf[i_][0], negm[i_]); s0 = MFMA16(kf[0][1], qf[i_][1], s0); s1 = MFMA16(kf[1][0], qf[i_][0], negm[i_]); s1 = MFMA16(kf[1][1], qf[i_][1], s1); \
        _Pragma("unroll") for (int ii = 0; ii < 4; ++ii) { sv[ii] = s0[ii]; sv[4 + ii] = s1[ii]; } } while (0)
#define ATT_LOADKV(kr0, kf, vf) do { const int kk = (kr0) + 8 * (c >> 2) + (c & 3); \
        _Pragma("unroll") for (int tt = 0; tt < 2; ++tt) _Pragma("unroll") for (int ks = 0; ks < 2; ++ks) kf[tt][ks] = *(const bf16x8*)(p.k + (size_t)(kk + 4 * tt) * D + h * 64 + ks * 32 + 8 * g); \
        _Pragma("unroll") for (int dt = 0; dt < 4; ++dt) vf[dt] = *(const bf16x8*)(p.vT + (size_t)(h * 64 + 16 * dt + c) * R + (kr0) + 8 * g); } while (0)

__device__ __forceinline__ void phase_attn(const P& p, char* smem) {
    const int tid = tid_(), lane = tid & 63, g = lane >> 4, c = lane & 15, wid = tid >> 6;
    const int gw = blockIdx.x * NWAVE + wid, ngw = gridDim.x * NWAVE;
    const int jb = __builtin_amdgcn_readfirstlane(wid & 3), rh = __builtin_amdgcn_readfirstlane(wid >> 2);
    float* relw = (float*)smem + wid * 576;
    bf16_t* KC = (bf16_t*)(smem + 18432); bf16_t* VC = KC + 256 * 72;
    bf16_t* RING = VC + 64 * 264;
    constexpr int SLOT = 2 * 64 * 72;
    for (int i = lane; i < 576; i += 64) relw[i] = 0.f;
    const int kc0 = jb == 0 ? 0 : (jb == 1 ? 8 : (jb == 2 ? 24 : 32));
    unsigned long long wm[8];
#pragma unroll
    for (int j = 0; j < 8; ++j) { const int qc = 16 * jb + c; const int wc0 = min(max(qc - 8, 0), 48); const int kc = kc0 + 8 * g + j; wm[j] = __ballot(kc >= wc0 && kc < wc0 + 16); }
    const unsigned one2 = (c == 0) ? 0x3f803f80u : 0u; const u32x4 one4 = {one2, one2, one2, one2}; const bf16x8 onesf = __builtin_bit_cast(bf16x8, one4);
    const int boff = kc0 - 16 * jb + 8 * g - c + 15;
    int hcur = -1;
    for (int wt = blockIdx.x; wt < NB * 16 * 8; wt += gridDim.x) {
        const int b = wt >> 7, h = (wt >> 3) & 15, R0 = (wt & 7) * 8;
        if (h != hcur) { asm volatile("s_waitcnt lgkmcnt(0)" ::: "memory");
            for (int i = lane; i < 465; i += 64) relw[48 + i] = p.na_relb[h * 465 + i] * 1.4426950408889634f;
            asm volatile("s_waitcnt lgkmcnt(0)" ::: "memory"); hcur = h; }
        const int ctx0 = NL + b * CT;
        const int rlo = min(max(R0 - 4, 0), 56), rhi = min(max(R0 + 3, 0), 56) + 8, nrow = rhi - rlo;
        const int skey = tid >> 3, sch = tid & 7;
        const bf16_t* ksrc = p.k + (size_t)(b * T + skey) * D + h * 64 + sch * 8;
        const bf16_t* vsrc = p.vT + (size_t)(h * 64 + skey) * R + b * T + sch * 8;
        __syncthreads();
        { const int key = tid >> 1, hh = tid & 1; const bf16_t* kcs = p.k + (size_t)(ctx0 + key) * D + h * 64 + hh * 32;
          const int dd = tid >> 3, seg = tid & 7; const bf16_t* vcs = p.vT + (size_t)(h * 64 + dd) * R + ctx0 + seg * 32;
          u32x4 kk[4], vv[4];
#pragma unroll
          for (int i = 0; i < 4; ++i) { kk[i] = *(const u32x4*)(kcs + 8 * i); vv[i] = *(const u32x4*)(vcs + 8 * i); }
          const u32x4 k0 = *(const u32x4*)(ksrc + (size_t)rlo * 64 * D), v0 = *(const u32x4*)(vsrc + rlo * 64);
#pragma unroll
          for (int i = 0; i < 4; ++i) { *(u32x4*)(KC + key * 72 + hh * 32 + 8 * i) = kk[i]; *(u32x4*)(VC + dd * 264 + seg * 32 + 8 * i) = vv[i]; }
          *(u32x4*)(RING + skey * 72 + sch * 8) = k0; *(u32x4*)(RING + 64 * 72 + skey * 72 + sch * 8) = v0; }
        __syncthreads();
        bf16x8 qf[4][2];
#pragma unroll
        for (int i = 0; i < 4; ++i)
#pragma unroll
            for (int ks = 0; ks < 2; ++ks) qf[i][ks] = *(const bf16x8*)(p.q + (size_t)(b * T + (R0 + 4 * rh + i) * 64 + 16 * jb + c) * D + h * 64 + ks * 32 + 8 * g);
        f32x4 O[4][4], OL[4], negm[4];
#pragma unroll
        for (int i = 0; i < 4; ++i) { negm[i] = (f32x4){0.f, 0.f, 0.f, 0.f}; OL[i] = (f32x4){0.f, 0.f, 0.f, 0.f};
#pragma unroll
            for (int dt = 0; dt < 4; ++dt) O[i][dt] = (f32x4){0.f, 0.f, 0.f, 0.f}; }
        bf16x8 kf[2][2], vf[4];
#pragma unroll 1
        for (int st = 0; st < 8; ++st) {
            { const int kk = st * 32 + 8 * (c >> 2) + (c & 3);
#pragma unroll
              for (int tt = 0; tt < 2; ++tt)
#pragma unroll
                  for (int ks = 0; ks < 2; ++ks) kf[tt][ks] = *(const bf16x8*)(KC + (kk + 4 * tt) * 72 + ks * 32 + 8 * g);
#pragma unroll
              for (int dt = 0; dt < 4; ++dt) vf[dt] = *(const bf16x8*)(VC + (16 * dt + c) * 264 + st * 32 + 8 * g); }
#pragma unroll
            for (int i = 0; i < 4; ++i) { float sv[8]; ATT_QK(i, kf); ATT_SOFTMAX_PV(i, vf, st == 0); }
        }
#pragma unroll 1
        for (int t = 0; t < nrow; ++t) {
            const int rho = rlo + t; const bf16_t* slot = RING + (t & 1) * SLOT;
            u32x4 kn, vn; const bool more = t + 1 < nrow;
            if (more) { kn = *(const u32x4*)(ksrc + (size_t)(rho + 1) * 64 * D); vn = *(const u32x4*)(vsrc + (rho + 1) * 64); }
            { const int kk = kc0 + 8 * (c >> 2) + (c & 3);
#pragma unroll
              for (int tt = 0; tt < 2; ++tt)
#pragma unroll
                  for (int ks = 0; ks < 2; ++ks) kf[tt][ks] = *(const bf16x8*)(slot + (kk + 4 * tt) * 72 + ks * 32 + 8 * g);
#pragma unroll
              for (int dt = 0; dt < 4; ++dt) vf[dt] = *(const bf16x8*)(slot + 64 * 72 + (16 * dt + c) * 72 + kc0 + 8 * g); }
#pragma unroll
            for (int i = 0; i < 4; ++i) {
                const int r = R0 + 4 * rh + i, r0 = min(max(r - 4, 0), 56);
                if (rho >= r0 && rho < r0 + 8) {
                    const float* rb = relw + 48 + (rho - r + 7) * 31 + boff;
                    float sv[8]; ATT_QK(i, kf);
#pragma unroll
                    for (int j = 0; j < 8; ++j) sv[j] = sel_mask(-1e30f, sv[j] + rb[j], wm[j]);
                    ATT_SOFTMAX_PV(i, vf, false);
                }
            }
            if (more) { bf16_t* nslot = RING + ((t + 1) & 1) * SLOT; *(u32x4*)(nslot + skey * 72 + sch * 8) = kn; *(u32x4*)(nslot + 64 * 72 + skey * 72 + sch * 8) = vn; }
            __syncthreads();
        }
#pragma unroll
        for (int i = 0; i < 4; ++i) { const float il = 1.f / __shfl(OL[i][0], c);
#pragma unroll
            for (int dt = 0; dt < 4; ++dt) st4bf(p.o + (size_t)(b * T + (R0 + 4 * rh + i) * 64 + 16 * jb + c) * D + h * 64 + 16 * dt + 4 * g, O[i][dt] * il); }
    }
    for (int t2 = gw; t2 < NB * 16 * 16; t2 += ngw) {
        const int b = t2 >> 8, h = (t2 >> 4) & 15, qrow0 = NL + b * CT + (t2 & 15) * 16, ctx0 = NL + b * CT;
        bf16x8 qf[1][2];
#pragma unroll
        for (int ks = 0; ks < 2; ++ks) qf[0][ks] = *(const bf16x8*)(p.q + (size_t)(qrow0 + c) * D + h * 64 + ks * 32 + 8 * g);
        f32x4 O[1][4], OL[1], negm[1];
        negm[0] = (f32x4){0.f, 0.f, 0.f, 0.f}; OL[0] = (f32x4){0.f, 0.f, 0.f, 0.f};
#pragma unroll
        for (int dt = 0; dt < 4; ++dt) O[0][dt] = (f32x4){0.f, 0.f, 0.f, 0.f};
        bf16x8 kfA[2][2], vfA[4], kfB[2][2], vfB[4];
        ATT_LOADKV(ctx0, kfA, vfA);
        for (int st = 0; st < 8; st += 2) {
            ATT_LOADKV(ctx0 + (st + 1) * 32, kfB, vfB);
            { float sv[8]; ATT_QK(0, kfA); ATT_SOFTMAX_PV(0, vfA, st == 0); }
            { const int nx = (st + 2 < 8) ? ctx0 + (st + 2) * 32 : ctx0; ATT_LOADKV(nx, kfA, vfA); }
            { float sv[8]; ATT_QK(0, kfB); ATT_SOFTMAX_PV(0, vfB, false); }
        }
        const float il = 1.f / __shfl(OL[0][0], c);
#pragma unroll
        for (int dt = 0; dt < 4; ++dt) st4bf(p.o + (size_t)(qrow0 + c) * D + h * 64 + 16 * dt + 4 * g, O[0][dt] * il);
    }
}
#undef ATT_SOFTMAX_PV
#undef ATT_THR
#undef ATT_QK
#undef ATT_LOADKV

template <int l> __device__ __forceinline__ void phase_post_mixer(const P& p, char* smem) {
    float* wr = (float*)smem;
    for (int idx = tid_(); idx < 1024 * 16 / 4; idx += NTHR) { const int k = idx >> 2, e4 = idx & 3; ((f32x4*)wr)[((k & 3) * 4 + e4) * 256 + (k >> 2)] = ((const f32x4*)(p.moe_wr + (size_t)l * 1024 * 16))[idx]; }
    __syncthreads();
    const int lane = tid_() & 63, gw = blockIdx.x * NWAVE + (tid_() >> 6), ngw = gridDim.x * NWAVE;
    const int nrow = l == 0 ? R : NL; const int cw = (((nrow + (int)gridDim.x - 1) / (int)gridDim.x) + 1) & ~1;
    f32x4 g1v[4], g2v[4], gtv[4], shv[4], scv[4];
#pragma unroll
    for (int j = 0; j < 4; ++j) { g1v[j] = ((const f32x4*)(p.norm_g + (l * 4 + 1) * D))[lane + 64 * j]; g2v[j] = ((const f32x4*)(p.norm_g + (l * 4 + 2) * D))[lane + 64 * j]; }
    int scur = -1;
    int row = blockIdx.x * cw + 2 * (tid_() >> 6); const int rend = min(nrow, (int)(blockIdx.x + 1) * cw);
#define PM_XIN(r) ((r) < NL ? p.x + (size_t)(r) * D : p.ctx + (size_t)((r) - NL) * D)
    while (row < rend) {
        const int s = row < NL ? (row >> 12) : 8;
        const bool two = (row + 1 < rend) && (((row + 1) < NL ? ((row + 1) >> 12) : 8) == s);
        const int row1 = two ? row + 1 : row;
        const int rr[2] = {row, row1};
        u32x2 yw[2][4]; f32x4 xv[2][4];
#pragma unroll
        for (int r = 0; r < 2; ++r)
#pragma unroll
            for (int j = 0; j < 4; ++j) { yw[r][j] = ((const u32x2*)(p.y + (size_t)rr[r] * D))[lane + 64 * j];
                if (l == 0) xv[r][j] = ((const f32x4*)PM_XIN(rr[r]))[lane + 64 * j];
                else { const u32x2 w = ((const u32x2*)(p.xs + (size_t)rr[r] * D))[lane + 64 * j]; xv[r][j] = (f32x4){bflo(w.x), bfhi(w.x), bflo(w.y), bfhi(w.y)}; } }
        if (s != scur) { const float* md = p.mod + (size_t)(l * 9 + s) * 6144; scur = s;
#pragma unroll
            for (int j = 0; j < 4; ++j) { gtv[j] = ((const f32x4*)(md + 2048))[lane + 64 * j]; shv[j] = ((const f32x4*)(md + 3072))[lane + 64 * j]; scv[j] = ((const f32x4*)(md + 4096))[lane + 64 * j]; } }
        f32x4 yv[2][4]; float ss[2] = {0.f, 0.f};
#pragma unroll
        for (int r = 0; r < 2; ++r)
#pragma unroll
            for (int j = 0; j < 4; ++j) { const u32x2 w = yw[r][j]; yv[r][j] = (f32x4){bflo(w.x), bfhi(w.x), bflo(w.y), bfhi(w.y)};
                ss[r] += yv[r][j].x * yv[r][j].x + yv[r][j].y * yv[r][j].y + yv[r][j].z * yv[r][j].z + yv[r][j].w * yv[r][j].w; }
        ss[0] = row_sum16(ss[0]); ss[1] = row_sum16(ss[1]); ss[0] = x16_sum(ss[0]); ss[1] = x16_sum(ss[1]); ss[0] = x32_sum(ss[0]); ss[1] = x32_sum(ss[1]);
        float rs[2], s2[2] = {0.f, 0.f};
#pragma unroll
        for (int r = 0; r < 2; ++r) rs[r] = 1.f / sqrtf(ss[r] * (1.f / D) + EPS);
#pragma unroll
        for (int r = 0; r < 2; ++r) { bf16_t* xo = (p.dry ? (bf16_t*)p.dryx : p.xs) + (size_t)rr[r] * D;
#pragma unroll
            for (int j = 0; j < 4; ++j) { const int ci = lane + 64 * j;
                xv[r][j] = xv[r][j] + gtv[j] * (yv[r][j] * rs[r] * g1v[j]); { u32x2 w; w.x = pk2(xv[r][j].x, xv[r][j].y); w.y = pk2(xv[r][j].z, xv[r][j].w); ((u32x2*)xo)[ci] = w; }
                s2[r] += xv[r][j].x * xv[r][j].x + xv[r][j].y * xv[r][j].y + xv[r][j].z * xv[r][j].z + xv[r][j].w * xv[r][j].w; } }
        s2[0] = row_sum16(s2[0]); s2[1] = row_sum16(s2[1]); s2[0] = x16_sum(s2[0]); s2[1] = x16_sum(s2[1]); s2[0] = x32_sum(s2[0]); s2[1] = x32_sum(s2[1]);
        float rs2[2];
#pragma unroll
        for (int r = 0; r < 2; ++r) rs2[r] = 1.f / sqrtf(s2[r] * (1.f / D) + EPS);
        float lg[2][16];
#pragma unroll
        for (int r = 0; r < 2; ++r)
#pragma unroll
            for (int e = 0; e < 16; ++e) lg[r][e] = 0.f;
#pragma unroll
        for (int j = 0; j < 4; ++j) { const int ci = lane + 64 * j;
            f32x4 hv[2];
#pragma unroll
            for (int r = 0; r < 2; ++r) { hv[r] = xv[r][j] * rs2[r] * g2v[j] * (scv[j] + 1.f) + shv[j];
                ((unsigned*)(p.h28 + (size_t)rr[r] * D))[ci] = pk4f8(hv[r].x, hv[r].y, hv[r].z, hv[r].w); }
#pragma unroll
            for (int i = 0; i < 4; ++i) {
#pragma unroll
                for (int e4 = 0; e4 < 4; ++e4) { const f32x4 wv = ((const f32x4*)wr)[(i * 4 + e4) * 256 + ci];
#pragma unroll
                    for (int r = 0; r < 2; ++r) { const float hx = hv[r][i]; lg[r][4 * e4] += hx * wv.x; lg[r][4 * e4 + 1] += hx * wv.y; lg[r][4 * e4 + 2] += hx * wv.z; lg[r][4 * e4 + 3] += hx * wv.w; } } }
            asm volatile("" ::: "memory"); }
        float r1[2];
#pragma unroll
        for (int r = 0; r < 2; ++r) { float r8[8], r4[4], r2[2];
#pragma unroll
            for (int e = 0; e < 8; ++e) { auto q2 = __builtin_amdgcn_permlane32_swap(__float_as_uint(lg[r][e]), __float_as_uint(lg[r][e + 8]), false, false); r8[e] = __uint_as_float(q2[0]) + __uint_as_float(q2[1]); }
#pragma unroll
            for (int e = 0; e < 4; ++e) { auto q2 = __builtin_amdgcn_permlane16_swap(__float_as_uint(r8[e]), __float_as_uint(r8[e + 4]), false, false); r4[e] = __uint_as_float(q2[0]) + __uint_as_float(q2[1]); }
            { const bool hi = lane & 8;
#pragma unroll
              for (int e = 0; e < 2; ++e) { const float keep = hi ? r4[e + 2] : r4[e], send = hi ? r4[e] : r4[e + 2]; r2[e] = keep + dpp_<0x128>(send); } }
            { const bool hi = lane & 4; const float keep = hi ? r2[1] : r2[0], send = hi ? r2[0] : r2[1]; r1[r] = keep + __shfl_xor(send, 4); }
            r1[r] += dpp_<0xB1>(r1[r]); r1[r] += dpp_<0x4E>(r1[r]); }
        const int eidx = ((lane >> 5) & 1) * 8 + ((lane >> 4) & 1) * 4 + ((lane >> 3) & 1) * 2 + ((lane >> 2) & 1);
#pragma unroll
        for (int r = 0; r < 2; ++r) { float mx = r1[r];
            mx = fmaxf(mx, dpp_<0x124>(mx)); mx = fmaxf(mx, dpp_<0x128>(mx)); mx = x16_max(mx); mx = x32_max(mx);
            const float ex = __expf(r1[r] - mx); float sum = ex;
            sum += dpp_<0x124>(sum); sum += dpp_<0x128>(sum); sum = x16_sum(sum); sum = x32_sum(sum);
            if ((lane & 3) == 0) p.aff[(size_t)rr[r] * 16 + eidx] = ex / sum; }
        row += 2 * NWAVE;
    }
#undef PM_XIN
}

__device__ __forceinline__ void phase_topk(const P& p, int l, char* smem) {
    unsigned* key = (unsigned*)smem;
    unsigned* cntw = key + 4096;
    int* wsum = (int*)(cntw + 16);
    int* rowsel = wsum + 16;
    const int tid = tid_(), lane = tid & 63, wid = tid >> 6;
    const int nset = l == 0 ? 16 : 8;
    const int cap_tot = l == 0 ? CAP0 : CAP1;
    for (int task = blockIdx.x; task < nset * NE; task += gridDim.x) {
        const int set = task / NE, e = task % NE;
        const bool lat = set < 8; const int n = lat ? T : CT, cap = lat ? CAPL : CAPC;
        const int row0 = lat ? set * T : NL + (set - 8) * CT;
        const int slot0 = lat ? set * CAPL : NB * CAPL + (set - 8) * CAPC;
        for (int i = tid; i < n; i += NTHR) key[i] = __float_as_uint(p.aff[(size_t)(row0 + i) * 16 + e]);
        __syncthreads();
        unsigned Tv = 0u;
        for (int bit = 30; bit >= 0; --bit) {
            const unsigned cand = Tv | (1u << bit); int cnt = 0;
            for (int i = tid; i < n; i += NTHR) cnt += (key[i] >= cand) ? 1 : 0;
            cnt = (int)wave_sum((float)cnt);
            if (lane == 0) cntw[wid] = (unsigned)cnt;
            __syncthreads();
            int tot = 0;
#pragma unroll
            for (int w2 = 0; w2 < 8; ++w2) tot += (int)cntw[w2];
            if (tot >= cap) Tv = cand;
            __syncthreads();
        }
        const int per = lat ? 8 : 1; const bool act = lat || tid < CT; const int i0 = tid * per;
        int ngt = 0, neq = 0;
        if (act) for (int j = 0; j < per; ++j) { const unsigned kv = key[i0 + j]; ngt += kv > Tv; neq += kv == Tv; }
        int sg = ngt, se = neq;
#pragma unroll
        for (int o = 1; o < 64; o <<= 1) { const int a = __shfl_up(sg, o), b2 = __shfl_up(se, o); if (lane >= o) { sg += a; se += b2; } }
        if (lane == 63) { wsum[wid] = sg; wsum[8 + wid] = se; }
        __syncthreads();
        int og = 0, oe = 0, totg = 0;
#pragma unroll
        for (int w2 = 0; w2 < 8; ++w2) { const int a = wsum[w2], b2 = wsum[8 + w2]; if (w2 < wid) { og += a; oe += b2; } totg += a; }
        int pg = og + sg - ngt, pe = oe + se - neq;
        const int need_eq = cap - totg;
        if (act) for (int j = 0; j < per; ++j) {
            const unsigned kv = key[i0 + j]; const int row = row0 + i0 + j; int slot = -1;
            if (kv > Tv) { slot = pg + min(pe, need_eq); ++pg; }
            else if (kv == Tv) { if (pe < need_eq) slot = pg + pe; ++pe; }
            p.inv[(size_t)row * 16 + e] = slot >= 0 ? slot0 + slot : -1;
            if (slot >= 0) { rowsel[slot] = row; p.list[e * CAP0 + slot0 + slot] = row; p.gatev[e * CAP0 + slot0 + slot] = __uint_as_float(kv); }
        }
        __syncthreads();
        __syncthreads();
    }
}

template <int l> __device__ __forceinline__ void phase_post_ffn(const P& p) {
    const int lane = tid_() & 63, gw = blockIdx.x * NWAVE + (tid_() >> 6), ngw = gridDim.x * NWAVE;
    const int nrow = l == 0 ? R : NL; const int cap_tot = l == 0 ? CAP0 : CAP1; const int npw = (nrow + ngw - 1) / ngw;
    f32x4 g3v[4], gnv[4], gtv[4], shv[4], scv[4];
#pragma unroll
    for (int j = 0; j < 4; ++j) { g3v[j] = ((const f32x4*)(p.norm_g + (l * 4 + 3) * D))[lane + 64 * j]; if (l == 0) gnv[j] = ((const f32x4*)(p.norm_g + ((l + 1) * 4 + 0) * D))[lane + 64 * j]; }
    int scur = -1;
    int row = gw * npw; const int rend = min(nrow, row + npw);
#define PF_GATHER(invreg, yd, cnt, rest) do { unsigned long long m_ = __ballot((invreg) >= 0); cnt = 0; \
        _Pragma("unroll") for (int k = 0; k < 4; ++k) { if (m_ != 0ull) { const int e_ = __builtin_ctzll(m_); m_ &= m_ - 1; const int sl_ = __builtin_amdgcn_readlane((invreg), e_); \
            const u32x2* src_ = (const u32x2*)(p.XgY + ((size_t)e_ * cap_tot + sl_) * D); _Pragma("unroll") for (int j = 0; j < 4; ++j) yd[k][j] = src_[lane + 64 * j]; cnt = k + 1; } } \
        rest = m_; } while (0)
    u32x2 xr[4], yr[4][4]; int ycnt = 0; unsigned long long yrest = 0ull; int invc = -1, invn = -1;
    if (row < rend) { invc = (lane < 16) ? p.inv[(size_t)row * 16 + lane] : -1;
        if (row + 1 < rend) invn = (lane < 16) ? p.inv[(size_t)(row + 1) * 16 + lane] : -1;
#pragma unroll
        for (int j = 0; j < 4; ++j) xr[j] = ((const u32x2*)(p.xs + (size_t)row * D))[lane + 64 * j];
        PF_GATHER(invc, yr, ycnt, yrest); }
    for (; row < rend; ++row) {
        u32x2 xrn[4], yrn[4][4]; int ycntn = 0; unsigned long long yrestn = 0ull; int invnn = -1;
        const bool hn = row + 1 < rend;
        if (hn) {
#pragma unroll
            for (int j = 0; j < 4; ++j) xrn[j] = ((const u32x2*)(p.xs + (size_t)(row + 1) * D))[lane + 64 * j];
            PF_GATHER(invn, yrn, ycntn, yrestn);
            if (row + 2 < rend) invnn = (lane < 16) ? p.inv[(size_t)(row + 2) * 16 + lane] : -1; }
        f32x4 mv[4], xv[4];
#pragma unroll
        for (int j = 0; j < 4; ++j) mv[j] = (f32x4){0.f, 0.f, 0.f, 0.f};
#pragma unroll
        for (int k = 0; k < 4; ++k) if (k < ycnt) {
#pragma unroll
            for (int j = 0; j < 4; ++j) { const u32x2 w = yr[k][j]; mv[j] += (f32x4){bflo(w.x), bfhi(w.x), bflo(w.y), bfhi(w.y)}; } }
        while (yrest) {
            const int e = __builtin_ctzll(yrest); yrest &= yrest - 1; const int sl = __builtin_amdgcn_readlane(invc, e);
            const u32x2* src = (const u32x2*)(p.XgY + ((size_t)e * cap_tot + sl) * D);
#pragma unroll
            for (int j = 0; j < 4; ++j) { const u32x2 w = src[lane + 64 * j]; mv[j] += (f32x4){bflo(w.x), bfhi(w.x), bflo(w.y), bfhi(w.y)}; } }
#pragma unroll
        for (int j = 0; j < 4; ++j) xv[j] = (f32x4){bflo(xr[j].x), bfhi(xr[j].x), bflo(xr[j].y), bfhi(xr[j].y)};
        const int s = row < NL ? (row >> 12) : 8;
        if (s != scur) { const float* md = p.mod + (size_t)(l * 9 + s) * 6144; const float* md1 = p.mod + (size_t)(1 * 9 + s) * 6144; scur = s;
#pragma unroll
            for (int j = 0; j < 4; ++j) { gtv[j] = ((const f32x4*)(md + 5120))[lane + 64 * j]; if (l == 0) { shv[j] = ((const f32x4*)md1)[lane + 64 * j]; scv[j] = ((const f32x4*)(md1 + 1024))[lane + 64 * j]; } } }
        float ss = 0.f;
#pragma unroll
        for (int j = 0; j < 4; ++j) ss += mv[j].x * mv[j].x + mv[j].y * mv[j].y + mv[j].z * mv[j].z + mv[j].w * mv[j].w;
        ss = wave_sum(ss); const float rs = 1.f / sqrtf(ss * (1.f / D) + EPS);
        float s2 = 0.f;
#pragma unroll
        for (int j = 0; j < 4; ++j) { const int ci = lane + 64 * j;
            xv[j] = xv[j] + gtv[j] * (mv[j] * rs * g3v[j]);
            if (l == 0) { u32x2 w; w.x = pk2(xv[j].x, xv[j].y); w.y = pk2(xv[j].z, xv[j].w); ((u32x2*)((p.dry ? (bf16_t*)p.dryx : p.xs) + (size_t)row * D))[ci] = w; }
            else ((f32x4*)((p.dry ? p.dryx : p.out) + (size_t)row * D))[ci] = xv[j];
            s2 += xv[j].x * xv[j].x + xv[j].y * xv[j].y + xv[j].z * xv[j].z + xv[j].w * xv[j].w; }
        if (l == 0) {
            s2 = wave_sum(s2); const float rs2 = 1.f / sqrtf(s2 * (1.f / D) + EPS);
#pragma unroll
            for (int j = 0; j < 4; ++j) { const int ci = lane + 64 * j;
                const f32x4 hv = xv[j] * rs2 * gnv[j] * (scv[j] + 1.f) + shv[j];
                if (MLIN_FP8) ((unsigned*)(p.h8 + (size_t)row * D))[ci] = pk4f8(hv.x, hv.y, hv.z, hv.w);
                else { u32x2 w; w.x = pk2(hv.x, hv.y); w.y = pk2(hv.z, hv.w); ((u32x2*)(p.h + (size_t)row * D))[ci] = w; } }
        }
        if (hn) { invc = invn; invn = invnn; ycnt = ycntn; yrest = yrestn;
#pragma unroll
            for (int j = 0; j < 4; ++j) { xr[j] = xrn[j];
#pragma unroll
                for (int k = 0; k < 4; ++k) yr[k][j] = yrn[k][j]; } }
    }
#undef PF_GATHER
}

constexpr int IST = 72;
constexpr int IMG_Q = 0, IMG_K = 64 * IST, IMG_KT = 2 * 64 * IST, IMG_VT = 3 * 64 * IST, IMG_ELEMS = 4 * 64 * IST;
constexpr int CT_ROWS = 80;
__device__ __forceinline__ int tswz(int row, int blk) { return ((blk ^ ((row >> 3) & 7)) << 3); }
__device__ __forceinline__ void phase_mscan(const P& p, char* smem) {
    bf16_t* img = (bf16_t*)smem;
    bf16_t* SG = img + 2 * IMG_ELEMS;
    bf16_t* CTi = SG + 64 * IST;
    float* scal = (float*)(CTi + 2 * CT_ROWS * IST);
    float* decs = scal + 2 * 5 * 64;
    const int tid = tid_(), lane = tid & 63, wid = tid >> 6, g0_ = lane >> 4, c0_ = lane & 15;
    for (int task = blockIdx.x; task < NB * 16 * 2; task += gridDim.x) {
        const int b = task >> 5, G = (task >> 1) & 15, vh = task & 1, dir = G >> 3, head = G & 7;
        bf16_t* hout = dir ? p.hb : p.hf;
        for (int i = tid; i < 2 * CT_ROWS * IST; i += NTHR) CTi[i] = 0;
        f32x4 accC[4];
#pragma unroll
        for (int tc = 0; tc < 4; ++tc) accC[tc] = (f32x4){0.f, 0.f, 0.f, 0.f};
        float nreg = 0.f, mstate = -1e30f;
        u32x4 sq0[2], sk0[2], sv0[2];
        auto rowof = [&](int cc, int j) -> int { const bool isc = cc < 4; const int Tn = isc ? CT : T; const int pp = (isc ? cc : cc - 4) * 64 + j; const int t = dir ? Tn - 1 - pp : pp; return (isc ? NL + b * CT : b * T) + t; };
#define MS_LOAD(cc, stq, stk, stv) do { _Pragma("unroll") for (int u = 0; u < 2; ++u) { const int pc = (tidl - 256) + 256 * u; const int j = pc >> 3, ch = pc & 7; const size_t row = (size_t)rowof(cc, j); \
            stq[u] = *(const u32x4*)(p.qm + row * 512 + head * 64 + ch * 8); stk[u] = *(const u32x4*)(p.km + row * 512 + head * 64 + ch * 8); \
            stv[u] = *(const u32x4*)(p.vm + row * D + head * 128 + vh * 64 + ch * 8); } } while (0)
#define MS_STORE(buf, stq, stk, stv) do { bf16_t* im = img + (buf) * IMG_ELEMS; _Pragma("unroll") for (int u = 0; u < 2; ++u) { const int pc = (tidl - 256) + 256 * u; const int j = pc >> 3, ch = pc & 7; \
            *(u32x4*)(im + IMG_Q + j * IST + ch * 8) = stq[u]; *(u32x4*)(im + IMG_K + j * IST + ch * 8) = stk[u]; \
            const unsigned kw[4] = {stk[u].x, stk[u].y, stk[u].z, stk[u].w}; const unsigned vw[4] = {stv[u].x, stv[u].y, stv[u].z, stv[u].w}; \
            _Pragma("unroll") for (int e2 = 0; e2 < 4; ++e2) { im[IMG_KT + (ch * 8 + 2 * e2) * IST + tswz(ch * 8, j >> 3) + (j & 7)] = (bf16_t)(kw[e2] & 0xffffu); im[IMG_KT + (ch * 8 + 2 * e2 + 1) * IST + tswz(ch * 8, j >> 3) + (j & 7)] = (bf16_t)(kw[e2] >> 16); \
                im[IMG_VT + (ch * 8 + 2 * e2) * IST + tswz(ch * 8, j >> 3) + (j & 7)] = (bf16_t)(vw[e2] & 0xffffu); im[IMG_VT + (ch * 8 + 2 * e2 + 1) * IST + tswz(ch * 8, j >> 3) + (j & 7)] = (bf16_t)(vw[e2] >> 16); } } } while (0)
#define MS_GLOAD(cc, g_ig, g_lf) do { const size_t row = (size_t)rowof(cc, lane); g_ig = p.gates[row * 32 + dir * 8 + head]; g_lf = p.gates[row * 32 + 16 + dir * 8 + head]; } while (0)
#define MS_SCAL(cc, buf, g_ig, g_lf) do { const float ig = g_ig, lf = g_lf; \
            const float bc = wave_scan_add(lf); \
            const float av = ig - bc; const float pm = wave_scan_max(av); \
            const float bend = __uint_as_float((unsigned)__builtin_amdgcn_readlane((int)__float_as_uint(bc), 63)), pm63 = __uint_as_float((unsigned)__builtin_amdgcn_readlane((int)__float_as_uint(pm), 63)); const float mnext = fmaxf(bend + mstate, bend + pm63); const float Mt = fmaxf(pm, mstate); \
            float* sb = scal + (buf) * 5 * 64; sb[lane] = av; sb[64 + lane] = Mt; sb[128 + lane] = __expf(mstate - Mt); sb[192 + lane] = __expf(-(bc + Mt)); sb[256 + lane] = __expf(bend + av - mnext); \
            if (lane == 0) decs[buf] = __expf(bend + mstate - mnext); mstate = mnext; } while (0)
        float gi0 = 0.f, gl0 = 0.f;
        int tidl = tid;
        if (wid >= 4) { MS_LOAD(0, sq0, sk0, sv0); }
        if (wid == 7) { MS_GLOAD(0, gi0, gl0); }
        __syncthreads();
        if (wid >= 4) { MS_STORE(0, sq0, sk0, sv0); MS_LOAD(1, sq0, sk0, sv0); }
        if (wid == 7) { MS_SCAL(0, 0, gi0, gl0); MS_GLOAD(1, gi0, gl0); }
        __syncthreads();
        for (int cc = 0; cc < 68; ++cc) {
            const int cur = cc & 1, nxt = cur ^ 1;
            int c_ = c0_, g_ = g0_; tidl = tid; asm volatile("" : "+v"(c_), "+v"(g_), "+v"(tidl));
            const bf16_t* im = img + cur * IMG_ELEMS; const float* sb = scal + cur * 5 * 64;
            if (wid >= 4) {
                if (cc + 1 < 68) { MS_STORE(nxt, sq0, sk0, sv0); if (wid == 7) { MS_SCAL(cc + 1, nxt, gi0, gl0); } }
                if (cc + 2 < 68) { MS_LOAD(cc + 2, sq0, sk0, sv0); if (wid == 7) { MS_GLOAD(cc + 2, gi0, gl0); } }
                const int wq = wid - 4; const float decay = decs[cur];
#pragma unroll
                for (int tc = 0; tc < 4; ++tc) accC[tc] = accC[tc] * decay;
#pragma unroll
                for (int ks = 0; ks < 2; ++ks) {
                    const u32x4 kraw = *(const u32x4*)(im + IMG_KT + (16 * wq + c_) * IST + tswz(16 * wq + c_, 4 * ks + g_));
                    const f32x4 w0 = *(const f32x4*)(sb + 256 + 32 * ks + 8 * g_), w1 = *(const f32x4*)(sb + 256 + 32 * ks + 8 * g_ + 4);
                    float t8[8] = {bflo(kraw.x) * w0.x, bfhi(kraw.x) * w0.y, bflo(kraw.y) * w0.z, bfhi(kraw.y) * w0.w, bflo(kraw.z) * w1.x, bfhi(kraw.z) * w1.y, bflo(kraw.w) * w1.z, bfhi(kraw.w) * w1.w};
                    const bf16x8 kwf = pack8(t8);
#pragma unroll
                    for (int tc = 0; tc < 4; ++tc) { const bf16x8 vtf = *(const bf16x8*)(im + IMG_VT + (16 * tc + c_) * IST + tswz(16 * tc + c_, 4 * ks + g_)); accC[tc] = MFMA16(kwf, vtf, accC[tc]); }
                }
                bf16_t* ctn = CTi + nxt * CT_ROWS * IST;
#pragma unroll
                for (int tc = 0; tc < 4; ++tc) { u32x2 w; w.x = pk2(accC[tc].x, accC[tc].y); w.y = pk2(accC[tc].z, accC[tc].w); *(u32x2*)(ctn + (16 * tc + c_) * IST + 16 * wq + 4 * g_) = w; }
                if (wid == 4) {
                    float sacc = 0.f;
#pragma unroll
                    for (int s8 = 0; s8 < 8; ++s8) { const u32x4 kr = *(const u32x4*)(im + IMG_KT + lane * IST + tswz(lane, s8)); const f32x4 w0 = *(const f32x4*)(sb + 256 + 8 * s8), w1 = *(const f32x4*)(sb + 256 + 8 * s8 + 4);
                        sacc += bflo(kr.x) * w0.x + bfhi(kr.x) * w0.y + bflo(kr.y) * w0.z + bfhi(kr.y) * w0.w + bflo(kr.z) * w1.x + bfhi(kr.z) * w1.y + bflo(kr.w) * w1.z + bfhi(kr.w) * w1.w; }
                    nreg = nreg * decay + sacc; ctn[64 * IST + lane] = f2bf(nreg);
                }
            } else if (cc >= 4) {
                const int tr = wid; const bf16_t* ctc = CTi + cur * CT_ROWS * IST; const int t = 16 * tr + c_;
                bf16x8 qB[2], kfr[4][2], vtf[4][2], ctf[4][2], nf[2];
#pragma unroll
                for (int ks = 0; ks < 2; ++ks) { qB[ks] = *(const bf16x8*)(im + IMG_Q + t * IST + 32 * ks + 8 * g_); nf[ks] = *(const bf16x8*)(ctc + (64 + c_) * IST + 32 * ks + 8 * g_); }
#pragma unroll
                for (int ts = 0; ts < 4; ++ts)
#pragma unroll
                    for (int ks = 0; ks < 2; ++ks) if (ts <= tr) kfr[ts][ks] = *(const bf16x8*)(im + IMG_K + (16 * ts + c_) * IST + 32 * ks + 8 * g_);
#pragma unroll
                for (int dvt = 0; dvt < 4; ++dvt)
#pragma unroll
                    for (int ks = 0; ks < 2; ++ks) { const int dvr = 16 * dvt + c_;
                        const u32x2 v0 = *(const u32x2*)(im + IMG_VT + dvr * IST + tswz(dvr, 4 * ks + (g_ >> 1)) + 4 * (g_ & 1));
                        const u32x2 v1 = *(const u32x2*)(im + IMG_VT + dvr * IST + tswz(dvr, 4 * ks + 2 + (g_ >> 1)) + 4 * (g_ & 1));
                        u32x4 vw; vw.x = v0.x; vw.y = v0.y; vw.z = v1.x; vw.w = v1.y; vtf[dvt][ks] = __builtin_bit_cast(bf16x8, vw);
                        ctf[dvt][ks] = *(const bf16x8*)(ctc + dvr * IST + 32 * ks + 8 * g_); }
                const float Mt = sb[64 + t], wint = sb[128 + t], en = sb[192 + t];
                f32x4 a4[4];
#pragma unroll
                for (int ts = 0; ts < 4; ++ts) a4[ts] = *(const f32x4*)(sb + 16 * ts + 4 * g_);
                unsigned pb[4][2]; float rsum = 0.f;
#pragma unroll
                for (int ts = 0; ts < 4; ++ts) {
                    pb[ts][0] = 0u; pb[ts][1] = 0u;
                    if (ts <= tr) {
                        f32x4 s0 = (f32x4){0.f, 0.f, 0.f, 0.f};
#pragma unroll
                        for (int ks = 0; ks < 2; ++ks) s0 = MFMA16(kfr[ts][ks], qB[ks], s0);
                        float pv[4];
#pragma unroll
                        for (int i = 0; i < 4; ++i) { const int sidx = 16 * ts + 4 * g_ + i; pv[i] = (sidx <= t) ? s0[i] * __expf(a4[ts][i] - Mt) : 0.f; rsum += pv[i]; }
                        pb[ts][0] = pk2(pv[0], pv[1]); pb[ts][1] = pk2(pv[2], pv[3]);
                    }
                }
                rsum = x16_sum(rsum); rsum = x32_sum(rsum);
                f32x4 qn4 = (f32x4){0.f, 0.f, 0.f, 0.f};
#pragma unroll
                for (int ks = 0; ks < 2; ++ks) qn4 = MFMA16(nf[ks], qB[ks], qn4);
                const float qn = __shfl(qn4[0], c_);
                const float den = rsum + wint * qn; const float inv_den = 1.f / fmaxf(fabsf(den), en);
                bf16x8 pB[2];
#pragma unroll
                for (int ks = 0; ks < 2; ++ks) { u32x4 w; w.x = pb[2 * ks][0]; w.y = pb[2 * ks][1]; w.z = pb[2 * ks + 1][0]; w.w = pb[2 * ks + 1][1]; pB[ks] = __builtin_bit_cast(bf16x8, w); }
                const size_t orow = (size_t)rowof(cc, t);
#pragma unroll
                for (int dvt = 0; dvt < 4; ++dvt) {
                    f32x4 nin = (f32x4){0.f, 0.f, 0.f, 0.f}, nit = nin;
#pragma unroll
                    for (int ks = 0; ks < 2; ++ks) { nit = MFMA16(ctf[dvt][ks], qB[ks], nit); nin = MFMA16(vtf[dvt][ks], pB[ks], nin); }
                    st4bf(hout + orow * D + head * 128 + vh * 64 + 16 * dvt + 4 * g_, (nin + nit * wint) * inv_den);
                }
            }
            asm volatile("s_waitcnt lgkmcnt(0)" ::: "memory"); __builtin_amdgcn_s_barrier(); asm volatile("" ::: "memory");
        }
#undef MS_LOAD
#undef MS_STORE
#undef MS_SCAL
#undef MS_GLOAD
    }
}

__device__ __forceinline__ void phase_readout(const P& p) {
    const int lane = tid_() & 63, gw = blockIdx.x * NWAVE + (tid_() >> 6), ngw = gridDim.x * NWAVE;
    for (int row = gw; row < NL; row += ngw) {
        float hs[16]; float ss = 0.f;
#pragma unroll
        for (int u = 0; u < 2; ++u) { const u32x4 a = ((const u32x4*)(p.hf + (size_t)row * D))[2 * lane + u], b2 = ((const u32x4*)(p.hb + (size_t)row * D))[2 * lane + u];
            const unsigned aw[4] = {a.x, a.y, a.z, a.w}, bw[4] = {b2.x, b2.y, b2.z, b2.w};
#pragma unroll
            for (int e = 0; e < 4; ++e) { const float v0 = bflo(aw[e]) + bflo(bw[e]), v1 = bfhi(aw[e]) + bfhi(bw[e]); hs[8 * u + 2 * e] = v0; hs[8 * u + 2 * e + 1] = v1; ss += v0 * v0 + v1 * v1; } }
        ss += dpp_<0xB1>(ss); ss += dpp_<0x4E>(ss); ss += dpp_<0x141>(ss);
        const float rs = 1.f / sqrtf(ss * (1.f / 128.f) + EPS);
#pragma unroll
        for (int u = 0; u < 2; ++u) { const u32x4 ov = ((const u32x4*)(p.om + (size_t)row * D))[2 * lane + u]; const unsigned ow[4] = {ov.x, ov.y, ov.z, ov.w}; u32x4 w; unsigned wo[4];
#pragma unroll
            for (int e = 0; e < 4; ++e) { const int col = 16 * lane + 8 * u + 2 * e; const float a0 = hs[8 * u + 2 * e] * rs * p.ml_normw[col] * sigmoidf_(bflo(ow[e])), a1 = hs[8 * u + 2 * e + 1] * rs * p.ml_normw[col + 1] * sigmoidf_(bfhi(ow[e])); wo[e] = pk2(a0, a1); }
            w.x = wo[0]; w.y = wo[1]; w.z = wo[2]; w.w = wo[3]; ((u32x4*)(p.ro + (size_t)row * D))[2 * lane + u] = w; }
    }
}


#define XB_TMO      128
#define XB_XCNT(j)  (256  + 64 * (j))
#define XB_XSUB(j)  (1280 + 64 * (j))
#define XB_XGEN(j)  (2304 + 64 * (j))
#define XB_TOP      3328
#define XB_TOPGEN   3392
#define XCD_BAR_WORDS 3456
#define XB_SPIN_CAP (1u << 18)
#define LAS __attribute__((address_space(3)))
__device__ __forceinline__ unsigned xb_ld(unsigned* p)              { return __hip_atomic_load(p, __ATOMIC_RELAXED, __HIP_MEMORY_SCOPE_AGENT); }
__device__ __forceinline__ unsigned xb_add(unsigned* p, unsigned v) { return __hip_atomic_fetch_add(p, v, __ATOMIC_RELAXED, __HIP_MEMORY_SCOPE_AGENT); }
__device__ __forceinline__ unsigned xb_xcc_id() { return (unsigned)__builtin_amdgcn_s_getreg((3 << 11) | 20) & 0xFu; }
#define XB_SPIN(cond, bar) do { unsigned _sp = 0; while (cond) { __builtin_amdgcn_s_sleep(1); \
    if ((++_sp & 255u) == 0u) { if (xb_ld(&(bar)[XB_TMO])) break; if (_sp > XB_SPIN_CAP) { atomicAdd(&(bar)[XB_TMO], 1u); break; } } } } while (0)
struct XcdBarrier { unsigned* bar; unsigned x; volatile LAS unsigned* st; };
__device__ __forceinline__ XcdBarrier xcd_barrier_post(unsigned* bar, volatile LAS unsigned* st) {
    XcdBarrier b; b.bar = bar; b.x = xb_xcc_id(); b.st = st;
    if (tid_() == 0) (void)xb_add(&bar[XB_XCNT(b.x)], 1u);
    return b;
}
__device__ __forceinline__ void xcd_barrier_complete(unsigned* bar, unsigned x, unsigned& nloc, unsigned& nx) {
    const unsigned G = gridDim.x * gridDim.y * gridDim.z;
    unsigned sum, cnt, mine, sp = 0u;
    for (;;) {
        sum = 0u; cnt = 0u; mine = 0u;
#pragma unroll
        for (unsigned j = 0; j < 16; ++j) { const unsigned c = xb_ld(&bar[XB_XCNT(j)]); sum += c; cnt += (c > 0u) ? 1u : 0u; mine = (j == x) ? c : mine; }
        if (sum == G) break;
        __builtin_amdgcn_s_sleep(1);
        if ((++sp & 255u) == 0u) { if (xb_ld(&bar[XB_TMO])) break; if (sp > XB_SPIN_CAP) { atomicAdd(&bar[XB_TMO], 1u); break; } }
    }
    nloc = mine > 0u ? mine : 1u; nx = cnt > 0u ? cnt : 1u;
}
__device__ __forceinline__ void xcd_barrier(const XcdBarrier& b) {
    asm volatile("s_waitcnt vmcnt(0)" ::: "memory");
    __syncthreads();
    if (tid_() == 0) {
        unsigned* bar = b.bar;
        __builtin_amdgcn_s_waitcnt(0);
        unsigned nloc = b.st[0], nx = b.st[1];
        if (nloc == 0u) { xcd_barrier_complete(bar, b.x, nloc, nx); b.st[0] = nloc; b.st[1] = nx; }
        const unsigned old = xb_add(&bar[XB_XSUB(b.x)], 1u);
        const unsigned gen = old / nloc;
        if (old + 1u == (gen + 1u) * nloc) {
            __builtin_amdgcn_fence(__ATOMIC_RELEASE, "agent");
            asm volatile("s_waitcnt vmcnt(0)" ::: "memory");
            const unsigned og = xb_add(&bar[XB_TOP], 1u);
            const unsigned tg = og / nx;
            if (og + 1u == (tg + 1u) * nx) xb_add(&bar[XB_TOPGEN], 1u);
            else XB_SPIN(xb_ld(&bar[XB_TOPGEN]) == tg, bar);
            __builtin_amdgcn_fence(__ATOMIC_ACQUIRE, "agent");
            xb_add(&bar[XB_XGEN(b.x)], 1u);
            asm volatile("s_waitcnt vmcnt(0)" ::: "memory");
        } else {
            XB_SPIN(xb_ld(&bar[XB_XGEN(b.x)]) == gen, bar);
            __builtin_amdgcn_fence(__ATOMIC_ACQUIRE, "agent");
            asm volatile("s_waitcnt vmcnt(0)" ::: "memory");
        }
    }
    __syncthreads();
}

constexpr int NPHASE = 19;
__global__ void __launch_bounds__(NTHR, 2) fwd_kernel(P p) {
    extern __shared__ __attribute__((aligned(16))) char smem[];
    cg::grid_group grid = cg::this_grid();
    PG8_LAS unsigned char* LDSP = (PG8_LAS unsigned char*)smem;
    volatile LAS unsigned* bst = (volatile LAS unsigned*)(LDSP + LDS_BYTES - 64);
    if (tid_() < 2) bst[tid_()] = 0u;
    __syncthreads();
    const XcdBarrier xbar = xcd_barrier_post(p.ctl, bst);
    if (p.ph_lo == 0x7fffffff) grid.sync();
#define GSYNC(k) do { xcd_barrier(xbar); } while (0)
#define CVFILL(base, limit, first_cu) convert_moe_fill(p, (float*)(smem + 20480) + (tid_() >> 6) * (64 * 65), (base), (limit), (first_cu))
    for (int i = 0; i < EXTRA_SYNCS; ++i) GSYNC(1);
    if (p.ph_lo <= 0 && 0 < p.ph_hi) { phase_mod(p, smem); __syncthreads(); convert_small_weights(p, smem); if (0 + 1 < p.ph_hi) GSYNC(0); }
    if (p.ph_lo <= 1 && 1 < p.ph_hi) { phase_norm0(p); if (1 + 1 < p.ph_hi) GSYNC(1); }
    if (p.ph_lo <= 2 && 2 < p.ph_hi) { { if (QKV_FP8) { SchedQKV S{(const char*)p.h8, (const char*)p.Wqkv8, 1, (int)gridDim.x, (int)blockIdx.x}; EpiQKV2 e{p.q, p.k, p.vT, WINV}; pg8::gemm_phase<true, false>(LDSP, D / 2, (size_t)128 * D, S, e); }
        else { SchedQKV S{(const char*)p.h, (const char*)p.Wqkv_t, 2, (int)gridDim.x, (int)blockIdx.x}; EpiQKV2 e{p.q, p.k, p.vT, 1.f}; pg8::gemm_phase<false, false>(LDSP, D, (size_t)128 * D * 2, S, e); } } CVFILL(0, 10000, 96); if (2 + 1 < p.ph_hi) GSYNC(2); }
    if (p.ph_lo <= 3 && 3 < p.ph_hi) { phase_attn(p, smem); if (3 + 1 < p.ph_hi) GSYNC(3); }
    if (p.ph_lo <= 4 && 4 < p.ph_hi) { { SchedPlain S{(const char*)p.o, (const char*)p.Wo0_t, R / 256, 4, D * 2, (int)gridDim.x, (int)blockIdx.x}; EpiYb e{p.y}; pg8::gemm_phase<false, false>(LDSP, D, (size_t)128 * D * 2, S, e); } CVFILL(10000, 21000, 32); if (4 + 1 < p.ph_hi) GSYNC(4); }
    if (p.ph_lo <= 5 && 5 < p.ph_hi) { phase_post_mixer<0>(p, smem); if (5 + 1 < p.ph_hi) GSYNC(5); }
    if (p.ph_lo <= 6 && 6 < p.ph_hi) { phase_topk(p, 0, smem); CVFILL(21000, CV_NITL, 0); if (6 + 1 < p.ph_hi) GSYNC(6); }
    if (p.ph_lo <= 7 && 7 < p.ph_hi) { { SchedMoeUpG S{p.h28, p.Wgu8, p.list, CAP0 / 256, (int)gridDim.x, (int)blockIdx.x}; EpiHb e{p.H8}; pg8::gemm_phase<true, true>(LDSP, D / 2, (size_t)2048 * D, S, e); } if (7 + 1 < p.ph_hi) GSYNC(7); }
    if (p.ph_lo <= 8 && 8 < p.ph_hi) { { SchedMoeDown S{p.H8, p.Wd8, CAP0 / 256, (int)gridDim.x, (int)blockIdx.x}; EpiYMb e{p.XgY, p.gatev, CAP0 / 256}; pg8::gemm_phase<true, false>(LDSP, HID / 2, (size_t)128 * HID, S, e); } CVFILL(CV_NITL, CV_NITL + 15000, 64); if (8 + 1 < p.ph_hi) GSYNC(8); }
    if (p.ph_lo <= 9 && 9 < p.ph_hi) { phase_post_ffn<0>(p); if (9 + 1 < p.ph_hi) GSYNC(9); }
    if (p.ph_lo <= 10 && 10 < p.ph_hi) { { if (MLIN_FP8) { SchedPlain S{(const char*)p.h8, (const char*)p.Win8, R / 256, 13, D, (int)gridDim.x, (int)blockIdx.x}; EpiMLINb e{p.qm, p.km, p.vm, p.om, p.rope, p.gates, p.ml_bgate, WINV}; pg8::gemm_phase<true, false>(LDSP, D / 2, (size_t)128 * D, S, e); }
        else { SchedPlain S{(const char*)p.h, (const char*)p.Win_t, R / 256, 13, D * 2, (int)gridDim.x, (int)blockIdx.x}; EpiMLINb e{p.qm, p.km, p.vm, p.om, p.rope, p.gates, p.ml_bgate, 1.f}; pg8::gemm_phase<false, false>(LDSP, D, (size_t)128 * D * 2, S, e); } } if (10 + 1 < p.ph_hi) GSYNC(10); }
    if (p.ph_lo <= 11 && 11 < p.ph_hi) { phase_mscan(p, smem); if (11 + 1 < p.ph_hi) GSYNC(11); }
    if (p.ph_lo <= 12 && 12 < p.ph_hi) { phase_readout(p); if (12 + 1 < p.ph_hi) GSYNC(12); }
    if (p.ph_lo <= 13 && 13 < p.ph_hi) { { SchedPlain S{(const char*)p.ro, (const char*)p.Wo1_t, NL / 256, 4, D * 2, (int)gridDim.x, (int)blockIdx.x}; EpiYb e{p.y}; pg8::gemm_phase<false, false>(LDSP, D, (size_t)128 * D * 2, S, e); } if (13 + 1 < p.ph_hi) GSYNC(13); }
    if (p.ph_lo <= 14 && 14 < p.ph_hi) { phase_post_mixer<1>(p, smem); if (14 + 1 < p.ph_hi) GSYNC(14); }
    if (p.ph_lo <= 15 && 15 < p.ph_hi) { phase_topk(p, 1, smem); CVFILL(CV_NITL + 15000, CV_NIT, 128); if (15 + 1 < p.ph_hi) GSYNC(15); }
    if (p.ph_lo <= 16 && 16 < p.ph_hi) { { SchedMoeUpG S{p.h28, p.Wgu8 + (size_t)NE * 4096 * D, p.list, CAP1 / 256, (int)gridDim.x, (int)blockIdx.x}; EpiHb e{p.H8}; pg8::gemm_phase<true, true>(LDSP, D / 2, (size_t)2048 * D, S, e); } if (16 + 1 < p.ph_hi) GSYNC(16); }
    if (p.ph_lo <= 17 && 17 < p.ph_hi) { { SchedMoeDown S{p.H8, p.Wd8 + (size_t)NE * 1024 * HID, CAP1 / 256, (int)gridDim.x, (int)blockIdx.x}; EpiYMb e{p.XgY, p.gatev, CAP1 / 256}; pg8::gemm_phase<true, false>(LDSP, HID / 2, (size_t)128 * HID, S, e); } if (17 + 1 < p.ph_hi) GSYNC(17); }
    if (p.ph_lo <= 18 && 18 < p.ph_hi) { phase_post_ffn<1>(p); if (18 + 1 < p.ph_hi) GSYNC(18); }
}

extern "C" void kernel_launch(void* const* d_in, const int* in_sizes, int n_in, void* d_out, int out_size, void* d_ws, size_t ws_size, hipStream_t stream) {
    constexpr size_t MiB = 1u << 20;
    static int grid = 0;
    if (grid == 0) {
        if (n_in != 18 || out_size != NL * D || ws_size < 960 * MiB) { fprintf(stderr, "kernel_launch: unexpected shapes n_in=%d out=%d ws=%zu\n", n_in, out_size, ws_size); grid = -1; return; }
        int dev = 0, cus = 0, per_cu = 0;
        hipGetDevice(&dev); hipDeviceGetAttribute(&cus, hipDeviceAttributeMultiprocessorCount, dev);
        hipFuncSetAttribute((const void*)fwd_kernel, hipFuncAttributeMaxDynamicSharedMemorySize, LDS_BYTES);
        hipOccupancyMaxActiveBlocksPerMultiprocessor(&per_cu, (const void*)fwd_kernel, NTHR, LDS_BYTES);
        if (per_cu < 1) { fprintf(stderr, "kernel_launch: occupancy query says %d blocks/CU\n", per_cu); per_cu = 1; }
        grid = cus;
        (void)hipGetLastError();
    }
    if (grid < 0) return;
    char* ws = (char*)d_ws;
    P p{};
    p.x = (const float*)d_in[0]; p.c = (const float*)d_in[1]; p.ctx = (const float*)d_in[2]; p.c_ctx = (const float*)d_in[3]; p.ada_w = (const float*)d_in[4]; p.ada_b = (const float*)d_in[5];
    p.norm_g = (const float*)d_in[6]; p.na_wqkv = (const float*)d_in[7]; p.na_wout = (const float*)d_in[8]; p.na_relb = (const float*)d_in[9]; p.ml_win = (const float*)d_in[10]; p.ml_bgate = (const float*)d_in[11];
    p.ml_normw = (const float*)d_in[12]; p.ml_wout = (const float*)d_in[13]; p.moe_wr = (const float*)d_in[14]; p.moe_wg = (const float*)d_in[15]; p.moe_wu = (const float*)d_in[16]; p.moe_wd = (const float*)d_in[17];
    p.out = (float*)d_out; p.ctl = (unsigned*)ws; p.xs = (bf16_t*)(ws + 880 * MiB);
    (void)hipMemsetAsync(ws, 0, 65536, stream);
    p.mod = (float*)(ws + 1 * MiB); p.rope = (float*)(ws + 2 * MiB); p.aff = (float*)(ws + 3 * MiB); p.inv = (int*)(ws + 6 * MiB); p.list = (int*)(ws + 9 * MiB); p.gatev = (float*)(ws + 10 * MiB);
    p.gates = (float*)(ws + 11 * MiB); p.xc = (float*)(ws + 16 * MiB);
    p.Wqkv_t = (bf16_t*)(ws + 24 * MiB); p.Wo0_t = (bf16_t*)(ws + 30 * MiB); p.Win_t = (bf16_t*)(ws + 32 * MiB); p.Wo1_t = (bf16_t*)(ws + 39 * MiB);
    p.Wgu8 = (fp8_t*)(ws + 48 * MiB); p.Wd8 = (fp8_t*)(ws + 176 * MiB);
    char* r1 = ws + 256 * MiB;
    p.h = (bf16_t*)r1; p.h8 = (fp8_t*)r1; p.Wqkv8 = (fp8_t*)(ws + 24 * MiB); p.Win8 = (fp8_t*)(ws + 32 * MiB); p.q = (bf16_t*)(r1 + 68 * MiB); p.k = (bf16_t*)(r1 + 136 * MiB); p.vT = (bf16_t*)(r1 + 204 * MiB); p.o = (bf16_t*)(r1 + 272 * MiB);
    p.H = (bf16_t*)r1; p.H8 = (fp8_t*)r1; p.dryx = (float*)(r1 + 136 * MiB);
    p.qm = (bf16_t*)(r1 + 68 * MiB); p.km = (bf16_t*)(r1 + 102 * MiB); p.vm = (bf16_t*)(r1 + 136 * MiB); p.om = (bf16_t*)(r1 + 204 * MiB); p.hf = (bf16_t*)(r1 + 272 * MiB); p.ro = (bf16_t*)(r1 + 68 * MiB);
    p.y = (bf16_t*)(ws + 596 * MiB); p.hb = p.y; p.h2 = (bf16_t*)(ws + 664 * MiB); p.h28 = (fp8_t*)(ws + 664 * MiB); p.XgY = (bf16_t*)(ws + 732 * MiB); p.Xg8 = (fp8_t*)(ws + 732 * MiB);
#if ONE_LAUNCH
    {
#if REP_PHASE >= 0
        const int nl = 3; const int los[3] = {0, REP_PHASE, REP_PHASE}, his[3] = {REP_PHASE, REP_PHASE + 1, NPHASE}; const int drys[3] = {0, 1, 0};
#else
        const int nl = 1; const int los[1] = {0}, his[1] = {NPHASE}; const int drys[1] = {0};
#endif
        for (int li = 0; li < nl; ++li) {
            if (los[li] >= his[li]) continue;
            p.ph_lo = los[li]; p.ph_hi = his[li]; p.dry = drys[li]; p.ctl = (unsigned*)ws + li * 4096;
            void* args[] = {&p};
            hipError_t e = hipLaunchCooperativeKernel((const void*)fwd_kernel, dim3(grid), dim3(NTHR), args, LDS_BYTES, stream);
            if (e != hipSuccess) fprintf(stderr, "cooperative launch failed: %s (grid %d)\n", hipGetErrorString(e), grid);
        }
    }
#else
    for (int ph = 0; ph < NPHASE; ++ph) { p.ph_lo = ph; p.ph_hi = ph + 1; hipLaunchKernelGGL(fwd_kernel, dim3(grid), dim3(NTHR), LDS_BYTES, stream, p); }
#endif
}
```

```cpp
#include <hip/hip_runtime.h>
#include <hip/hip_cooperative_groups.h>
#include <cstdio>
#include <cstdint>
namespace cg = cooperative_groups;

#ifndef REP_PHASE
#define REP_PHASE -1
#endif
#ifndef EXTRA_SYNCS
#define EXTRA_SYNCS 0
#endif
#ifndef QKV_FP8
#define QKV_FP8 0
#endif
#ifndef MLIN_FP8
#define MLIN_FP8 1
#endif
#ifndef ONE_LAUNCH
#define ONE_LAUNCH 1
#endif

typedef unsigned short bf16_t;
typedef unsigned char fp8_t;
typedef short bf16x8 __attribute__((ext_vector_type(8)));
typedef float f32x4 __attribute__((ext_vector_type(4)));
typedef float f32x2 __attribute__((ext_vector_type(2)));
typedef unsigned u32x4 __attribute__((ext_vector_type(4)));
typedef unsigned u32x2 __attribute__((ext_vector_type(2)));
typedef __bf16 bf16x2_t __attribute__((ext_vector_type(2)));

constexpr int D = 1024, NB = 8, T = 4096, CT = 256, NL = NB * T, NC = NB * CT, R = NL + NC;
constexpr int NE = 16, HID = 2048, CAPL = 512, CAPC = 32, CAP0 = NB * CAPL + NB * CAPC  , CAP1 = NB * CAPL  ;
constexpr int MLW = 3104;
constexpr float EPS = 1e-6f;
constexpr int NTHR = 512, NWAVE = 8;
constexpr int LDS_BYTES = 163840;

struct P {
    const float *x, *c, *ctx, *c_ctx, *ada_w, *ada_b, *norm_g, *na_wqkv, *na_wout, *na_relb, *ml_win, *ml_bgate, *ml_normw, *ml_wout, *moe_wr, *moe_wg, *moe_wu, *moe_wd;
    float* out; unsigned* ctl;
    float *mod, *rope, *aff, *gatev, *gates, *xc;
    int *inv, *list;
    bf16_t *h, *q, *k, *vT, *o, *y, *h2, *XgY, *H, *qm, *km, *vm, *om, *hf, *hb, *ro, *xs;
    bf16_t *Wqkv_t, *Wo0_t, *Win_t, *Wo1_t;
    fp8_t *Wgu8, *Wd8, *h28, *Xg8, *H8, *h8, *Wqkv8, *Win8;
    float* dryx; int ph_lo, ph_hi, dry, pad_;
};

__device__ __forceinline__ int tid_() { int t = (int)threadIdx.x; asm volatile("" : "+v"(t)); return t; }
__device__ __forceinline__ unsigned pk2(float lo, float hi) { f32x2 v = {lo, hi}; bf16x2_t b = __builtin_convertvector(v, bf16x2_t); return __builtin_bit_cast(unsigned, b); }
__device__ __forceinline__ float bflo(unsigned u) { return __uint_as_float(u << 16); }
__device__ __forceinline__ float bfhi(unsigned u) { return __uint_as_float(u & 0xffff0000u); }
__device__ __forceinline__ bf16_t f2bf(float f) { return (bf16_t)(pk2(f, 0.f) & 0xffffu); }
__device__ __forceinline__ float bf2f(bf16_t h) { return __uint_as_float(((unsigned)h) << 16); }
template <int CTRL> __device__ __forceinline__ float dpp_(float v) { return __uint_as_float((unsigned)__builtin_amdgcn_update_dpp(0, (int)__float_as_uint(v), CTRL, 0xf, 0xf, true)); }
__device__ __forceinline__ float x16_sum(float v) { auto r = __builtin_amdgcn_permlane16_swap(__float_as_uint(v), __float_as_uint(v), false, false); return __uint_as_float(r[0]) + __uint_as_float(r[1]); }
__device__ __forceinline__ float x32_sum(float v) { auto r = __builtin_amdgcn_permlane32_swap(__float_as_uint(v), __float_as_uint(v), false, false); return __uint_as_float(r[0]) + __uint_as_float(r[1]); }
__device__ __forceinline__ float x16_max(float v) { auto r = __builtin_amdgcn_permlane16_swap(__float_as_uint(v), __float_as_uint(v), false, false); return fmaxf(__uint_as_float(r[0]), __uint_as_float(r[1])); }
__device__ __forceinline__ float x32_max(float v) { auto r = __builtin_amdgcn_permlane32_swap(__float_as_uint(v), __float_as_uint(v), false, false); return fmaxf(__uint_as_float(r[0]), __uint_as_float(r[1])); }
__device__ __forceinline__ float row_sum16(float v) { v += dpp_<0xB1>(v); v += dpp_<0x4E>(v); v += dpp_<0x141>(v); v += dpp_<0x140>(v); return v; }
__device__ __forceinline__ float wave_sum(float v) { v = row_sum16(v); v = x16_sum(v); return x32_sum(v); }
template <int CTRL, int RMASK> __device__ __forceinline__ float dppo_(float old, float v) { return __uint_as_float((unsigned)__builtin_amdgcn_update_dpp((int)__float_as_uint(old), (int)__float_as_uint(v), CTRL, RMASK, 0xf, false)); }
__device__ __forceinline__ float wave_scan_add(float x) {
    x += dppo_<0x111, 0xf>(0.f, x); x += dppo_<0x112, 0xf>(0.f, x); x += dppo_<0x114, 0xf>(0.f, x); x += dppo_<0x118, 0xf>(0.f, x);
    x += dppo_<0x142, 0xa>(0.f, x); x += dppo_<0x143, 0xc>(0.f, x); return x;
}
__device__ __forceinline__ float wave_scan_max(float x) {
    x = fmaxf(x, dppo_<0x111, 0xf>(-3e38f, x)); x = fmaxf(x, dppo_<0x112, 0xf>(-3e38f, x)); x = fmaxf(x, dppo_<0x114, 0xf>(-3e38f, x)); x = fmaxf(x, dppo_<0x118, 0xf>(-3e38f, x));
    x = fmaxf(x, dppo_<0x142, 0xa>(-3e38f, x)); x = fmaxf(x, dppo_<0x143, 0xc>(-3e38f, x)); return x;
}
__device__ __forceinline__ float sigmoidf_(float v) { return 1.f / (1.f + __expf(-v)); }
__device__ __forceinline__ float siluf_(float v) { return v * __builtin_amdgcn_rcpf(1.f + __builtin_amdgcn_exp2f(-1.4426950408889634f * v)); }
__device__ __forceinline__ bf16x8 pack8(const float* t) {
    u32x4 w; w.x = pk2(t[0], t[1]); w.y = pk2(t[2], t[3]); w.z = pk2(t[4], t[5]); w.w = pk2(t[6], t[7]); return __builtin_bit_cast(bf16x8, w);
}
typedef int v8i_t __attribute__((ext_vector_type(8)));
typedef int v4i_t __attribute__((ext_vector_type(4)));
constexpr float WSCALE = 32.f, WINV = 1.f / 32.f;
__device__ __forceinline__ unsigned pk4f8(float a, float b, float c, float d) { int w = __builtin_amdgcn_cvt_pk_fp8_f32(a, b, 0, false); w = __builtin_amdgcn_cvt_pk_fp8_f32(c, d, w, true); return (unsigned)w; }
#define MFMA16(a, b, c) __builtin_amdgcn_mfma_f32_16x16x32_bf16((a), (b), (c), 0, 0, 0)

__device__ __forceinline__ void phase_mod(const P& p, char* smem) {
    float* sc = (float*)smem;
    float* red = sc + 9 * 1024;
    for (int i = tid_(); i < 9 * 1024; i += NTHR) { const int s = i >> 10, k = i & 1023; const float v = s < 8 ? p.c[s * 1024 + k] : p.c_ctx[k]; sc[i] = v / (1.f + expf(-v)); }
    __syncthreads();
    const int kg = tid_() >> 6, col = tid_() & 63;
    for (int item = blockIdx.x; item < 192; item += gridDim.x) {
        const int l = item / 96, n0 = (item % 96) * 64;
        float acc[9];
#pragma unroll
        for (int s = 0; s < 9; ++s) acc[s] = 0.f;
        const float* w = p.ada_w + ((size_t)l * 1024 + kg * 128) * 6144 + n0 + col;
        for (int k = 0; k < 128; ++k) {
            const float wv = w[(size_t)k * 6144];
#pragma unroll
            for (int s = 0; s < 9; ++s) acc[s] += sc[s * 1024 + kg * 128 + k] * wv;
        }
#pragma unroll
        for (int s = 0; s < 9; ++s) red[(kg * 9 + s) * 64 + col] = acc[s];
        __syncthreads();
        for (int i = tid_(); i < 576; i += NTHR) {
            const int s = i >> 6, cc = i & 63; float t = 0.f;
#pragma unroll
            for (int k2 = 0; k2 < 8; ++k2) t += red[(k2 * 9 + s) * 64 + cc];
            p.mod[(l * 9 + s) * 6144 + n0 + cc] = t + p.ada_b[l * 6144 + n0 + cc];
        }
        __syncthreads();
    }
    if (blockIdx.x == gridDim.x - 1) {
        for (int i = tid_(); i < 64 * 16; i += NTHR) {
            const int pos = i >> 4, j = i & 15;
            const float inv = exp2f(-(float)j * (13.287712379549449f / 16.0f));
            const float ang = (float)pos * inv;
            float rev = ang * 0.15915494309189535f; rev = rev - floorf(rev);
            p.rope[2 * i] = __builtin_amdgcn_cosf(rev); p.rope[2 * i + 1] = __builtin_amdgcn_sinf(rev);
        }
    }
}

__device__ __forceinline__ void phase_norm0(const P& p) {
    const int lane = tid_() & 63, gw = blockIdx.x * NWAVE + (tid_() >> 6), ngw = gridDim.x * NWAVE;
    const f32x4* g4 = (const f32x4*)(p.norm_g);
    for (int row = gw; row < R; row += ngw) {
        const float* src = row < NL ? p.x + (size_t)row * D : p.ctx + (size_t)(row - NL) * D;
        const int s = row < NL ? (row >> 12) : 8;
        const float* md = p.mod + (size_t)(0 * 9 + s) * 6144;
        f32x4 v[4]; float ss = 0.f;
#pragma unroll
        for (int j = 0; j < 4; ++j) { v[j] = ((const f32x4*)src)[lane + 64 * j]; ss += v[j].x * v[j].x + v[j].y * v[j].y + v[j].z * v[j].z + v[j].w * v[j].w; }
        ss = wave_sum(ss); const float rs = 1.f / sqrtf(ss * (1.f / D) + EPS);
        u32x2* dst = (u32x2*)(p.h + (size_t)row * D);
#pragma unroll
        for (int j = 0; j < 4; ++j) {
            const int ci = lane + 64 * j; const f32x4 gg = g4[ci], sh = ((const f32x4*)md)[ci], scv = ((const f32x4*)(md + 1024))[ci];
            f32x4 o = v[j] * rs * gg * (scv + 1.f) + sh;
            if (QKV_FP8) ((unsigned*)(p.h8 + (size_t)row * D))[ci] = pk4f8(o.x, o.y, o.z, o.w);
            else { u32x2 w; w.x = pk2(o.x, o.y); w.y = pk2(o.z, o.w); dst[ci] = w; }
        }
    }
}

template <bool DUAL, class Epi>
__device__ __forceinline__ void gemm_naive(const bf16_t* A, int lda, size_t strideA, const float* B, const float* B2, int ldb, size_t strideB, int nbatch, int M, int N, int K, const Epi& epi) {
    const int lane = tid_() & 63, g = lane >> 4, c = lane & 15;
    const int gw = blockIdx.x * NWAVE + (tid_() >> 6), ngw = gridDim.x * NWAVE;
    const int tm = M / 64, tn = N / 32; const long per = (long)tm * tn, ntile = per * nbatch;
    for (long t = gw; t < ntile; t += ngw) {
        const int bt = (int)(t / per); const int rem = (int)(t % per); const int mt = rem / tn, nt = rem % tn;
        f32x4 acc[4][2], acc2[4][2];
#pragma unroll
        for (int m = 0; m < 4; ++m)
#pragma unroll
            for (int n = 0; n < 2; ++n) { acc[m][n] = (f32x4){0.f, 0.f, 0.f, 0.f}; acc2[m][n] = (f32x4){0.f, 0.f, 0.f, 0.f}; }
        const bf16_t* Ab = A + (size_t)bt * strideA + (size_t)(mt * 64 + c) * lda + 8 * g;
        const float* Bb = B + (size_t)bt * strideB + (size_t)(8 * g) * ldb + nt * 32 + c;
        const float* Bb2 = DUAL ? B2 + (size_t)bt * strideB + (size_t)(8 * g) * ldb + nt * 32 + c : nullptr;
        for (int k0 = 0; k0 < K; k0 += 32) {
            bf16x8 af[4], bfr[2], bfr2[2];
#pragma unroll
            for (int m = 0; m < 4; ++m) af[m] = *(const bf16x8*)(Ab + (size_t)(m * 16) * lda + k0);
#pragma unroll
            for (int n = 0; n < 2; ++n) {
                float t8[8];
#pragma unroll
                for (int j = 0; j < 8; ++j) t8[j] = Bb[(size_t)(k0 + j) * ldb + n * 16];
                bfr[n] = pack8(t8);
                if (DUAL) {
#pragma unroll
                    for (int j = 0; j < 8; ++j) t8[j] = Bb2[(size_t)(k0 + j) * ldb + n * 16];
                    bfr2[n] = pack8(t8);
                }
            }
#pragma unroll
            for (int m = 0; m < 4; ++m)
#pragma unroll
                for (int n = 0; n < 2; ++n) { acc[m][n] = MFMA16(bfr[n], af[m], acc[m][n]); if (DUAL) acc2[m][n] = MFMA16(bfr2[n], af[m], acc2[m][n]); }
        }
#pragma unroll
        for (int m = 0; m < 4; ++m) epi(bt, mt * 64 + m * 16 + c, nt * 32 + 4 * g, acc[m][0], acc[m][1], acc2[m][0], acc2[m][1]);
    }
}

__device__ __forceinline__ void st4bf(bf16_t* dst, f32x4 v) { u32x2 w; w.x = pk2(v.x, v.y); w.y = pk2(v.z, v.w); *(u32x2*)dst = w; }

struct EpiQKV {
    bf16_t *q, *k, *vT;
    __device__ __forceinline__ void one(int row, int col, f32x4 v) const {
        if (col < 1024) st4bf(q + (size_t)row * D + col, v * 0.125f);
        else if (col < 2048) st4bf(k + (size_t)row * D + (col - 1024), v);
        else { const int d = col - 2048;
#pragma unroll
            for (int i = 0; i < 4; ++i) vT[(size_t)(d + i) * R + row] = f2bf(v[i]); }
    }
    __device__ __forceinline__ void operator()(int, int row, int col, f32x4 v0, f32x4 v1, f32x4, f32x4) const { one(row, col, v0); one(row, col + 16, v1); }
};
struct EpiY {
    bf16_t* y;
    __device__ __forceinline__ void operator()(int, int row, int col, f32x4 v0, f32x4 v1, f32x4, f32x4) const { st4bf(y + (size_t)row * D + col, v0); st4bf(y + (size_t)row * D + col + 16, v1); }
};
struct EpiH {
    bf16_t* H; int cap;
    __device__ __forceinline__ void operator()(int bt, int row, int col, f32x4 a0, f32x4 a1, f32x4 u0, f32x4 u1) const {
        bf16_t* d = H + ((size_t)bt * cap + row) * HID + col;
        f32x4 r0, r1;
#pragma unroll
        for (int i = 0; i < 4; ++i) { r0[i] = siluf_(a0[i]) * u0[i]; r1[i] = siluf_(a1[i]) * u1[i]; }
        st4bf(d, r0); st4bf(d + 16, r1);
    }
};
struct EpiYM {
    bf16_t* Y; const float* gatev; int cap;
    __device__ __forceinline__ void operator()(int bt, int row, int col, f32x4 v0, f32x4 v1, f32x4, f32x4) const {
        const float gv = gatev[bt * CAP0 + row]; bf16_t* d = Y + ((size_t)bt * cap + row) * D + col;
        st4bf(d, v0 * gv); st4bf(d + 16, v1 * gv);
    }
};
struct EpiMLIN {
    bf16_t *qm, *km, *vm, *om; float* gates; const float* rope; const float* bgate;
    __device__ __forceinline__ void operator()(int, int row, int col, f32x4 v0, f32x4 v1, f32x4, f32x4) const {
        if (col < 1024) {
            const bool isk = col >= 512; const int cc = isk ? col - 512 : col;
            if (row < NL) {
                const int t = row & 4095; const int hd = cc & 63; const int pos = (hd < 32) ? (t >> 6) : (t & 63); const int j0 = hd & 15;
                const float* rp = rope + (pos * 16 + j0) * 2;
#pragma unroll
                for (int i = 0; i < 4; ++i) { const float cs = rp[2 * i], sn = rp[2 * i + 1]; const float a = v0[i], b = v1[i]; v0[i] = a * cs - b * sn; v1[i] = a * sn + b * cs; }
            }
            if (isk) { v0 = v0 * 0.125f; v1 = v1 * 0.125f; }
            bf16_t* d = (isk ? km : qm) + (size_t)row * 512 + cc; st4bf(d, v0); st4bf(d + 16, v1);
        } else if (col < 2048) { bf16_t* d = vm + (size_t)row * D + (col - 1024); st4bf(d, v0); st4bf(d + 16, v1); }
        else if (col < 3072) { bf16_t* d = om + (size_t)row * D + (col - 2048); st4bf(d, v0); st4bf(d + 16, v1); }
        else { const int gc = col - 3072;
            f32x4 o0, o1;
#pragma unroll
            for (int i = 0; i < 4; ++i) { o0[i] = v0[i] + bgate[gc + i]; const float f = v1[i] + bgate[gc + 16 + i]; o1[i] = fminf(f, 0.f) - log1pf(__expf(-fabsf(f))); }
            *(f32x4*)(gates + (size_t)row * 32 + gc) = o0; *(f32x4*)(gates + (size_t)row * 32 + gc + 16) = o1; }
    }
};


namespace pg8 {
#define PG8_LAS __attribute__((address_space(3)))
#define LAS __attribute__((address_space(3)))
constexpr int BM = 256, BK = 64, HALF = 128, HTB = HALF * BK * 2, STAGE_BYTES = 8 * HTB, NXCD = 8, WGM = 8;
__host__ __device__ __forceinline__ int lds_byte(int r, int c) { const int st = (r >> 4) * 2 + (c >> 5), rr = r & 15, cc = c & 31, ob = rr * 64 + cc * 2; return st * 1024 + (ob ^ (((ob >> 9) & 1) << 5)); }
__host__ __device__ __forceinline__ void stage_rc(int b, int& R_, int& C_) { const int st = b / 1024, sb = b % 1024, swz = sb ^ (((sb >> 9) & 1) << 5); R_ = (st >> 1) * 16 + swz / 64; C_ = (st & 1) * 32 + (swz % 64) / 2; }
__host__ __device__ __forceinline__ int perm32(int rho) { const int n = rho >> 4, i = rho & 15; return 8 * (i >> 2) + 4 * n + (i & 3); }
struct Unit { const char* a; const char* b; const int* lst; int pm, pn, job; };
__device__ __forceinline__ void tile_of(int L, int nM, int nN, int& pm, int& pn) {
    const int nwg = nM * nN; int wgid = L; { const int q = nwg / NXCD, r = nwg % NXCD, xcd = wgid % NXCD, off = wgid / NXCD; wgid = (xcd < r ? xcd * (q + 1) : r * (q + 1) + (xcd - r) * q) + off; }
    const int nig = WGM * nN, gid = wgid / nig, fm = gid * WGM, gsz = (nM - fm) < WGM ? (nM - fm) : WGM;
    pm = fm + ((wgid % nig) % gsz); pn = (wgid % nig) / gsz;
}
template <bool FP8, bool GATH, class Epi, class Sched>
__device__ __forceinline__ void gemm_phase(PG8_LAS unsigned char* lds, const int K, const size_t bhs  , const Sched& S, const Epi& E) {
    const int tid = tid_(), wid = __builtin_amdgcn_readfirstlane(tid >> 6), lane = tid & 63, wr = wid >> 2, wc = wid & 3, fr = lane & 15, fq = lane >> 4;
    const int nt = K / BK;
    unsigned voffA[2], voffB[2]; int arow[2]; unsigned acol[2];
#pragma unroll
    for (int i = 0; i < 2; ++i) { int R_, C_; stage_rc(tid * 16 + i * 8192, R_, C_); const int Rb = Epi::PERM ? ((R_ & ~31) + perm32(R_ & 31)) : R_;
        voffA[i] = (unsigned)(R_ * K + C_) * 2u; voffB[i] = (unsigned)(Rb * K + C_) * 2u; arow[i] = R_; acol[i] = (unsigned)C_ * 2u; }
    unsigned vA[2][2], vAn[2][2];
#define PG8_LOADOFF(dst, u) do { _Pragma("unroll") for (int h_ = 0; h_ < 2; ++h_) _Pragma("unroll") for (int i_ = 0; i_ < 2; ++i_) dst[h_][i_] = (unsigned)(u).lst[h_ * HALF + arow[i_]] * (unsigned)(K * 2) + acol[i_]; } while (0)
#define PG8_STAGE_A(bufoff, aptr, h, nx) do { if constexpr (GATH) { unsigned vv_[2]; vv_[0] = (nx) ? vAn[h][0] : vA[h][0]; vv_[1] = (nx) ? vAn[h][1] : vA[h][1]; PG8_STAGE(bufoff, aptr, vv_); } \
        else { PG8_STAGE(bufoff, (aptr) + (h) * ahs, voffA); } } while (0)
    const size_t kstep = (size_t)(BK * 2);
    const size_t ahs = (size_t)HALF * K * 2;
    const unsigned ldsw = (unsigned)wid * 1024u;
    const int aoff = lds_byte(wr * 64 + fr, fq * 8), boff = lds_byte(wc * 32 + fr, fq * 8);
#define PG8_SA(b, h) (((b) * 2 + (h)) * HTB)
#define PG8_SB(b, h) ((4 + (b) * 2 + (h)) * HTB)
#define PG8_STAGE(bufoff, gbase, voff) do { _Pragma("unroll") for (int _i = 0; _i < 2; ++_i) \
        __builtin_amdgcn_global_load_lds((const unsigned*)((const char*)(gbase) + (voff)[_i]), (PG8_LAS unsigned*)(lds + (bufoff) + ldsw + _i * 8192), 16, 0, 0); } while (0)
#define PG8_LDA(dst, b, h) do { _Pragma("unroll") for (int m = 0; m < 4; ++m) _Pragma("unroll") for (int k = 0; k < 2; ++k) dst[m][k] = *(const PG8_LAS bf16x8*)(lds + PG8_SA(b, h) + aoff + m * 2048 + k * 1024); } while (0)
#define PG8_LDB(dst, b, h) do { _Pragma("unroll") for (int n = 0; n < 2; ++n) _Pragma("unroll") for (int k = 0; k < 2; ++k) dst[n][k] = *(const PG8_LAS bf16x8*)(lds + PG8_SB(b, h) + boff + n * 2048 + k * 1024); } while (0)
#define PG8_CAT(x, y) __builtin_shufflevector(__builtin_bit_cast(v4i_t, x), __builtin_bit_cast(v4i_t, y), 0, 1, 2, 3, 4, 5, 6, 7)
#define PG8_MMA(ai, bj, At, Bt) do { __builtin_amdgcn_s_setprio(1); if constexpr (FP8) { _Pragma("unroll") for (int m = 0; m < 4; ++m) _Pragma("unroll") for (int n = 0; n < 2; ++n) \
        { const v8i_t a8_ = PG8_CAT(Bt[n][0], Bt[n][1]), b8_ = PG8_CAT(At[m][0], At[m][1]); asm volatile("v_mfma_scale_f32_16x16x128_f8f6f4 %0, %1, %2, %0, %3, %3 op_sel_hi:[0,0,0]" : "+v"(acc[ai][bj][m][n]) : "v"(a8_), "v"(b8_), "v"(sc127)); } } \
        else { _Pragma("unroll") for (int m = 0; m < 4; ++m) _Pragma("unroll") for (int n = 0; n < 2; ++n) _Pragma("unroll") for (int k = 0; k < 2; ++k) \
        acc[ai][bj][m][n] = __builtin_amdgcn_mfma_f32_16x16x32_bf16(Bt[n][k], At[m][k], acc[ai][bj][m][n], 0, 0, 0); } __builtin_amdgcn_s_setprio(0); } while (0)
#define PG8_WAIT_V(n) asm volatile("s_waitcnt vmcnt(" #n ")" ::: "memory")
#define PG8_WAIT_L(n) asm volatile("s_waitcnt lgkmcnt(" #n ")" ::: "memory")
#define PG8_BAR __builtin_amdgcn_s_barrier()
#define PG8_SCHED __builtin_amdgcn_sched_barrier(0)
    Unit cur, nxt; int ui = 0;
    if (!S.next(0, cur)) return;
    int sc127 = 0x7f7f7f7f; asm volatile("" : "+v"(sc127));
    f32x4 acc[2][2][4][2];
#pragma unroll
    for (int a = 0; a < 2; ++a)
#pragma unroll
        for (int b = 0; b < 2; ++b)
#pragma unroll
            for (int m = 0; m < 4; ++m)
#pragma unroll
                for (int n = 0; n < 2; ++n) acc[a][b][m][n] = (f32x4){0.f, 0.f, 0.f, 0.f};
    bf16x8 At[4][2], B0[2][2], B1[2][2];
    const char* cA = cur.a; const char* cB = cur.b;
    if constexpr (GATH) { PG8_LOADOFF(vA, cur); PG8_LOADOFF(vAn, cur); }
    PG8_STAGE(PG8_SB(0, 0), cB, voffB); PG8_STAGE(PG8_SB(0, 1), cB + bhs, voffB); PG8_STAGE_A(PG8_SA(0, 0), cA, 0, false); PG8_STAGE_A(PG8_SA(0, 1), cA, 1, false);
    if (wr == 1) PG8_BAR;
    PG8_WAIT_V(2); PG8_BAR;
    PG8_STAGE(PG8_SB(1, 0), cB + kstep, voffB); PG8_STAGE_A(PG8_SA(1, 0), cA + kstep, 0, false); PG8_STAGE(PG8_SB(1, 1), cB + bhs + kstep, voffB);
    PG8_WAIT_V(6); PG8_BAR;
    for (;;) {
        const bool has_next = S.next(ui + 1, nxt);
        const char* nA = has_next ? nxt.a : cA; const char* nB = has_next ? nxt.b : cB;
        if constexpr (GATH) { if (has_next) { PG8_LOADOFF(vAn, nxt); } }
        for (int t = 0; t < nt; t += 2) {
            const bool last = (t == nt - 2);
            const char* a1 = cA + (size_t)(t + 1) * kstep;
            const char* a2 = last ? nA : cA + (size_t)(t + 2) * kstep; const char* b2 = last ? nB : cB + (size_t)(t + 2) * kstep;
            const char* a3 = a2 + kstep; const char* b3 = b2 + kstep; const bool nx = last && has_next;
            PG8_LDB(B0, 0, 0); PG8_LDB(B1, 0, 1); PG8_SCHED; PG8_LDA(At, 0, 0); PG8_STAGE_A(PG8_SA(1, 1), a1, 1, false);
            PG8_WAIT_V(8); PG8_WAIT_L(0); PG8_BAR; PG8_MMA(0, 0, At, B0); PG8_MMA(0, 1, At, B1); PG8_BAR; PG8_SCHED;
            PG8_LDA(At, 0, 1); PG8_STAGE(PG8_SB(0, 0), b2, voffB); PG8_STAGE(PG8_SB(0, 1), b2 + bhs, voffB); PG8_STAGE_A(PG8_SA(0, 0), a2, 0, nx);
            PG8_WAIT_V(8); PG8_WAIT_L(0); PG8_BAR; PG8_MMA(1, 0, At, B0); PG8_MMA(1, 1, At, B1); PG8_BAR; PG8_SCHED;
            PG8_LDB(B0, 1, 0); PG8_LDB(B1, 1, 1); PG8_SCHED; PG8_LDA(At, 1, 0); PG8_STAGE_A(PG8_SA(0, 1), a2, 1, nx);
            PG8_WAIT_V(8); PG8_WAIT_L(0); PG8_BAR; PG8_MMA(0, 0, At, B0); PG8_MMA(0, 1, At, B1); PG8_BAR; PG8_SCHED;
            PG8_LDA(At, 1, 1); PG8_STAGE(PG8_SB(1, 0), b3, voffB); PG8_STAGE(PG8_SB(1, 1), b3 + bhs, voffB); PG8_STAGE_A(PG8_SA(1, 0), a3, 0, nx);
            PG8_WAIT_V(8); PG8_WAIT_L(0); PG8_BAR; PG8_MMA(1, 0, At, B0); PG8_MMA(1, 1, At, B1); PG8_BAR; PG8_SCHED;
        }
        if (wr == 0) PG8_BAR;
        if constexpr (FP8) { asm volatile("s_nop 15\n\ts_nop 15" ::: "memory"); }
        E(acc, cur, wr, wc, fr, fq);
        if (!has_next) break;
#pragma unroll
        for (int a = 0; a < 2; ++a)
#pragma unroll
            for (int b = 0; b < 2; ++b)
#pragma unroll
                for (int m = 0; m < 4; ++m)
#pragma unroll
                    for (int n = 0; n < 2; ++n) acc[a][b][m][n] = (f32x4){0.f, 0.f, 0.f, 0.f};
        cur = nxt; cA = nA; cB = nB; ++ui;
        if constexpr (GATH) { _Pragma("unroll") for (int h_ = 0; h_ < 2; ++h_) _Pragma("unroll") for (int i_ = 0; i_ < 2; ++i_) vA[h_][i_] = vAn[h_][i_]; }
        if (wr == 1) PG8_BAR;
    }
    PG8_WAIT_V(0);
    PG8_BAR;
#undef PG8_SA
#undef PG8_SB
#undef PG8_STAGE
#undef PG8_STAGE_A
#undef PG8_LOADOFF
#undef PG8_LDA
#undef PG8_LDB
#undef PG8_MMA
#undef PG8_CAT
#undef PG8_WAIT_V
#undef PG8_WAIT_L
#undef PG8_BAR
#undef PG8_SCHED
}
}

typedef float accT[2][2][4][2][4];
__device__ __forceinline__ void st8bf(bf16_t* dst, f32x4 a, f32x4 b) { u32x4 w; w.x = pk2(a.x, a.y); w.y = pk2(a.z, a.w); w.z = pk2(b.x, b.y); w.w = pk2(b.z, b.w); *(u32x4*)dst = w; }

struct SchedQKV {
    const char *h, *W; int es, G, c;
    __device__ __forceinline__ bool next(int i, pg8::Unit& u) const {
        const int L = i * G + c; if (L >= 1088 + 544) return false;
        if (L < 1088) { pg8::tile_of(L, 136, 8, u.pm, u.pn); u.job = 0; u.a = h + (size_t)u.pm * 256 * D * es; u.b = W + (size_t)u.pn * 256 * D * es; }
        else { pg8::tile_of(L - 1088, 4, 136, u.pm, u.pn); u.job = 1; u.a = W + (size_t)(2048 + u.pm * 256) * D * es; u.b = h + (size_t)u.pn * 256 * D * es; }
        return true;
    }
};
struct SchedPlain {
    const char *A, *Bt; int nM, nN, KB  , G, c;
    __device__ __forceinline__ bool next(int i, pg8::Unit& u) const {
        const int L = i * G + c; if (L >= nM * nN) return false;
        pg8::tile_of(L, nM, nN, u.pm, u.pn); u.job = 0; u.a = A + (size_t)u.pm * 256 * KB; u.b = Bt + (size_t)u.pn * 256 * KB; return true;
    }
};
struct SchedMoeUp {
    const fp8_t *Xg, *Wgu; int tmE, G, c;
    __device__ __forceinline__ bool next(int i, pg8::Unit& u) const {
        const int L = i * G + c; if (L >= NE * tmE * 16) return false;
        pg8::tile_of(L, NE * tmE, 16, u.pm, u.pn); const int e = u.pm / tmE; u.job = e;
        u.a = (const char*)(Xg + (size_t)u.pm * 256 * D); u.b = (const char*)(Wgu + ((size_t)e * 4096 + u.pn * 128) * D); return true;
    }
};
struct SchedMoeUpG {
    const fp8_t *h28, *Wgu; const int* list; int tmE, G, c;
    __device__ __forceinline__ bool next(int i, pg8::Unit& u) const {
        const int L = i * G + c; if (L >= NE * tmE * 16) return false;
        pg8::tile_of(L, NE * tmE, 16, u.pm, u.pn); const int e = u.pm / tmE; u.job = e;
        u.a = (const char*)h28; u.lst = list + e * CAP0 + (u.pm - e * tmE) * 256; u.b = (const char*)(Wgu + ((size_t)e * 4096 + u.pn * 128) * D); return true;
    }
};
struct SchedMoeDown {
    const fp8_t *Hh, *Wd; int tmE, G, c;
    __device__ __forceinline__ bool next(int i, pg8::Unit& u) const {
        const int L = i * G + c; if (L >= NE * tmE * 4) return false;
        pg8::tile_of(L, NE * tmE, 4, u.pm, u.pn); const int e = u.pm / tmE; u.job = e;
        u.a = (const char*)(Hh + (size_t)u.pm * 256 * HID); u.b = (const char*)(Wd + ((size_t)e * 1024 + u.pn * 256) * HID); return true;
    }
};
struct EpiQKV2 { static constexpr bool PERM = true;
    bf16_t *q, *k, *vT; float osc;
    __device__ __forceinline__ void operator()(const f32x4 (&acc)[2][2][4][2], const pg8::Unit& u, int wr, int wc, int fr, int fq) const {
        const int row0 = u.pm * 256 + wr * 64 + fr, col0 = u.pn * 256 + wc * 32 + 8 * fq;
        bf16_t* base; size_t ld; float sc = 1.f;
        if (u.job == 0) { ld = D; if (col0 < 1024) { base = q + col0; sc = 0.125f * 1.4426950408889634f; } else base = k + (col0 - 1024); }
        else { ld = R; base = vT + col0; }
#pragma unroll
        for (int ai = 0; ai < 2; ++ai)
#pragma unroll
            for (int m = 0; m < 4; ++m) { bf16_t* rp = base + (size_t)(row0 + ai * 128 + m * 16) * ld;
#pragma unroll
                for (int bj = 0; bj < 2; ++bj) st8bf(rp + bj * 128, acc[ai][bj][m][0] * (sc * osc), acc[ai][bj][m][1] * (sc * osc)); }
    }
};
struct EpiYb { static constexpr bool PERM = true;
    bf16_t* y;
    __device__ __forceinline__ void operator()(const f32x4 (&acc)[2][2][4][2], const pg8::Unit& u, int wr, int wc, int fr, int fq) const {
        const int row0 = u.pm * 256 + wr * 64 + fr, col0 = u.pn * 256 + wc * 32 + 8 * fq;
#pragma unroll
        for (int ai = 0; ai < 2; ++ai)
#pragma unroll
            for (int m = 0; m < 4; ++m) { bf16_t* rp = y + (size_t)(row0 + ai * 128 + m * 16) * D + col0;
#pragma unroll
                for (int bj = 0; bj < 2; ++bj) st8bf(rp + bj * 128, acc[ai][bj][m][0], acc[ai][bj][m][1]); }
    }
};
struct EpiHb { static constexpr bool PERM = true;
    fp8_t* H;
    __device__ __forceinline__ void operator()(const f32x4 (&acc)[2][2][4][2], const pg8::Unit& u, int wr, int wc, int fr, int fq) const {
        const int row0 = u.pm * 256 + wr * 64 + fr, col0 = u.pn * 128 + wc * 32 + 8 * fq;
#pragma unroll
        for (int ai = 0; ai < 2; ++ai)
#pragma unroll
            for (int m = 0; m < 4; ++m) { f32x4 r0, r1;
#pragma unroll
                for (int i = 0; i < 4; ++i) { r0[i] = siluf_(acc[ai][0][m][0][i] * WINV) * (acc[ai][1][m][0][i] * WINV); r1[i] = siluf_(acc[ai][0][m][1][i] * WINV) * (acc[ai][1][m][1][i] * WINV); }
                u32x2 w; w.x = pk4f8(r0.x, r0.y, r0.z, r0.w); w.y = pk4f8(r1.x, r1.y, r1.z, r1.w); *(u32x2*)(H + (size_t)(row0 + ai * 128 + m * 16) * HID + col0) = w; }
    }
};
struct EpiYMb { static constexpr bool PERM = true;
    bf16_t* Y; const float* gatev; int tmE;
    __device__ __forceinline__ void operator()(const f32x4 (&acc)[2][2][4][2], const pg8::Unit& u, int wr, int wc, int fr, int fq) const {
        const int row0 = u.pm * 256 + wr * 64 + fr, col0 = u.pn * 256 + wc * 32 + 8 * fq; const int e = u.job, rl0 = row0 - e * tmE * 256;
#pragma unroll
        for (int ai = 0; ai < 2; ++ai)
#pragma unroll
            for (int m = 0; m < 4; ++m) { const float gv = gatev[e * CAP0 + rl0 + ai * 128 + m * 16] * WINV; bf16_t* rp = Y + (size_t)(row0 + ai * 128 + m * 16) * D + col0;
#pragma unroll
                for (int bj = 0; bj < 2; ++bj) st8bf(rp + bj * 128, acc[ai][bj][m][0] * gv, acc[ai][bj][m][1] * gv); }
    }
};
struct EpiMLINb { static constexpr bool PERM = false;
    bf16_t *qm, *km, *vm, *om; const float* rope; float* gates; const float* bgate; float osc;
    __device__ __forceinline__ void operator()(const f32x4 (&acc)[2][2][4][2], const pg8::Unit& u, int wr, int wc, int fr, int fq) const {
        const int row0 = u.pm * 256 + wr * 64 + fr;
        if (u.pn == 12) {
            if (wc == 0) { const int gc = 4 * fq; const f32x4 bi = *(const f32x4*)(bgate + gc), bf = *(const f32x4*)(bgate + 16 + gc);
#pragma unroll
                for (int ai = 0; ai < 2; ++ai)
#pragma unroll
                    for (int m = 0; m < 4; ++m) { const int row = row0 + ai * 128 + m * 16; const f32x4 o0 = acc[ai][0][m][0] * osc + bi; const f32x4 fv = acc[ai][0][m][1] * osc + bf; f32x4 o1;
#pragma unroll
                        for (int i = 0; i < 4; ++i) o1[i] = fminf(fv[i], 0.f) - log1pf(__expf(-fabsf(fv[i])));
                        *(f32x4*)(gates + (size_t)row * 32 + gc) = o0; *(f32x4*)(gates + (size_t)row * 32 + gc + 16) = o1; } }
        } else if (u.pn < 4) {
            const bool isk = u.pn >= 2; bf16_t* dst = isk ? km : qm; const float sc = (isk ? 0.125f : 1.f) * osc;
            const bool lat = (u.pm * 256) < NL;
#pragma unroll
            for (int bj = 0; bj < 2; ++bj) {
                const int cc = (u.pn & 1) * 256 + bj * 128 + wc * 32 + 4 * fq; const int hd = cc & 63;
#pragma unroll
                for (int ai = 0; ai < 2; ++ai)
#pragma unroll
                    for (int m = 0; m < 4; ++m) { const int row = row0 + ai * 128 + m * 16; f32x4 v0 = acc[ai][bj][m][0], v1 = acc[ai][bj][m][1];
                        if (lat) { const int t = row & 4095; const int pos = (hd < 32) ? (t >> 6) : (t & 63); const f32x4* rp = (const f32x4*)(rope + (pos * 16 + (hd & 15)) * 2);
                            const f32x4 r01 = rp[0], r23 = rp[1];
                            const float c0 = r01.x, s0 = r01.y, c1 = r01.z, s1 = r01.w, c2 = r23.x, s2 = r23.y, c3 = r23.z, s3 = r23.w;
                            f32x4 a = v0, b = v1;
                            v0 = (f32x4){a.x * c0 - b.x * s0, a.y * c1 - b.y * s1, a.z * c2 - b.z * s2, a.w * c3 - b.w * s3};
                            v1 = (f32x4){a.x * s0 + b.x * c0, a.y * s1 + b.y * c1, a.z * s2 + b.z * c2, a.w * s3 + b.w * c3}; }
                        bf16_t* d = dst + (size_t)row * 512 + cc; st4bf(d, v0 * sc); st4bf(d + 16, v1 * sc);
                        asm volatile("" ::: "memory"); }
            }
        } else {
            bf16_t* dst = (u.pn < 8 ? vm : om) + ((u.pn & 3) * 256) + wc * 32 + 4 * fq;
#pragma unroll
            for (int bj = 0; bj < 2; ++bj)
#pragma unroll
                for (int ai = 0; ai < 2; ++ai)
#pragma unroll
                    for (int m = 0; m < 4; ++m) { bf16_t* d = dst + (size_t)(row0 + ai * 128 + m * 16) * D + bj * 128; st4bf(d, acc[ai][bj][m][0] * osc); st4bf(d + 16, acc[ai][bj][m][1] * osc); }
        }
    }
};
struct EpiGates {
    float* gates; const float* bgate;
    __device__ __forceinline__ void operator()(int, int row, int gc, f32x4 v0, f32x4 v1, f32x4, f32x4) const {
        f32x4 o0, o1;
#pragma unroll
        for (int i = 0; i < 4; ++i) { o0[i] = v0[i] + bgate[gc + i]; const float f = v1[i] + bgate[gc + 16 + i]; o1[i] = fminf(f, 0.f) - log1pf(__expf(-fabsf(f))); }
        *(f32x4*)(gates + (size_t)row * 32 + gc) = o0; *(f32x4*)(gates + (size_t)row * 32 + gc + 16) = o1;
    }
};

__device__ __forceinline__ void transpose_item(const float* W, int K, int N, bf16_t* WT, int row_off, float* scr, int item, int lane) {
    const int nblk = N / 32, kb = item / nblk, nb = item % nblk, k0 = 64 * kb, n0 = 32 * nb;
#pragma unroll 8
    for (int i = 0; i < 32; ++i) { const int kk = 2 * i + (lane >> 5); scr[kk * 33 + (lane & 31)] = W[(size_t)(k0 + kk) * N + n0 + (lane & 31)]; }
    asm volatile("s_waitcnt lgkmcnt(0)" ::: "memory");
    const int c8 = lane & 7;
#pragma unroll
    for (int j = 0; j < 4; ++j) { const int n = (lane >> 3) + 8 * j; const float* s2 = scr + (8 * c8) * 33 + n;
        u32x4 o; o.x = pk2(s2[0 * 33], s2[1 * 33]); o.y = pk2(s2[2 * 33], s2[3 * 33]); o.z = pk2(s2[4 * 33], s2[5 * 33]); o.w = pk2(s2[6 * 33], s2[7 * 33]);
        *(u32x4*)(WT + (size_t)(row_off + n0 + n) * K + k0 + 8 * c8) = o; }
    asm volatile("s_waitcnt lgkmcnt(0)" ::: "memory");
}
__device__ __forceinline__ void transpose_item8(const float* W, int K, int N, fp8_t* WT, int row_off, float* scr, int item, int lane) {
    const int nblk = N / 32, kb = item / nblk, nb = item % nblk, k0 = 64 * kb, n0 = 32 * nb;
#pragma unroll 8
    for (int i = 0; i < 32; ++i) { const int kk = 2 * i + (lane >> 5); scr[kk * 33 + (lane & 31)] = W[(size_t)(k0 + kk) * N + n0 + (lane & 31)]; }
    asm volatile("s_waitcnt lgkmcnt(0)" ::: "memory");
    const int c8 = lane & 7;
#pragma unroll
    for (int j = 0; j < 4; ++j) { const int n = (lane >> 3) + 8 * j; const float* s2 = scr + (8 * c8) * 33 + n;
        u32x2 o; o.x = pk4f8(s2[0 * 33] * WSCALE, s2[1 * 33] * WSCALE, s2[2 * 33] * WSCALE, s2[3 * 33] * WSCALE); o.y = pk4f8(s2[4 * 33] * WSCALE, s2[5 * 33] * WSCALE, s2[6 * 33] * WSCALE, s2[7 * 33] * WSCALE);
        *(u32x2*)(WT + (size_t)(row_off + n0 + n) * K + k0 + 8 * c8) = o; }
    asm volatile("s_waitcnt lgkmcnt(0)" ::: "memory");
}
constexpr int CV_IPM = 512, CV_IPE = 3 * CV_IPM, CV_NITL = NE * CV_IPE, CV_NIT = 2 * CV_NITL;
constexpr int CV_CNT_WORD = 15360;
__device__ __forceinline__ int cv_pull(unsigned* cnt, int lane) { unsigned v = 0; if (lane == 0) v = __hip_atomic_fetch_add(cnt, 1u, __ATOMIC_RELAXED, __HIP_MEMORY_SCOPE_AGENT); return (int)__builtin_amdgcn_readfirstlane(v); }
__device__ __forceinline__ void convert_moe_fill(const P& p, float* scr, int base, int limit, int first_cu) {
    const int lane = tid_() & 63; if (gridDim.x != 256) first_cu = 0;
    if ((int)blockIdx.x < first_cu) return;
    const int nw = ((int)gridDim.x - first_cu) * NWAVE; int idx = base + ((int)blockIdx.x - first_cu) * NWAVE + (tid_() >> 6);
    const int lr = lane >> 4, lc = lane & 15;
#define CV_DECODE(idx_, W_, N_, K_, WT_, k0_, n0_) do { const int l_ = (idx_) / CV_NITL, it_ = (idx_) % CV_NITL; const int e_ = it_ / CV_IPE, r_ = it_ % CV_IPE, mat_ = r_ / CV_IPM, q_ = r_ % CV_IPM; \
        if (mat_ == 0) { W_ = p.moe_wg + ((size_t)l_ * NE + e_) * D * HID; N_ = HID; K_ = D; WT_ = p.Wgu8 + ((size_t)l_ * NE + e_) * 4096 * D; } \
        else if (mat_ == 1) { W_ = p.moe_wu + ((size_t)l_ * NE + e_) * D * HID; N_ = HID; K_ = D; WT_ = p.Wgu8 + (((size_t)l_ * NE + e_) * 4096 + 2048) * D; } \
        else { W_ = p.moe_wd + ((size_t)l_ * NE + e_) * HID * D; N_ = D; K_ = HID; WT_ = p.Wd8 + ((size_t)l_ * NE + e_) * 1024 * HID; } \
        const int nb_ = N_ / 64; k0_ = 64 * (q_ / nb_); n0_ = 64 * (q_ % nb_); } while (0)
    f32x4 v[16];
    const float* W; int N, K, k0, n0; fp8_t* WT;
    if (idx < limit) { CV_DECODE(idx, W, N, K, WT, k0, n0);
#pragma unroll
        for (int i = 0; i < 16; ++i) v[i] = *(const f32x4*)(W + (size_t)(k0 + 4 * i + lr) * N + n0 + 4 * lc); }
    while (idx < limit) {
#pragma unroll
        for (int i = 0; i < 16; ++i) { float* d = scr + (4 * i + lr) * 65 + 4 * lc; d[0] = v[i].x; d[1] = v[i].y; d[2] = v[i].z; d[3] = v[i].w; }
        fp8_t* WTc = WT; const int Kc = K, k0c = k0, n0c = n0;
        idx += nw;
        if (idx < limit) { CV_DECODE(idx, W, N, K, WT, k0, n0);
#pragma unroll
            for (int i = 0; i < 16; ++i) v[i] = *(const f32x4*)(W + (size_t)(k0 + 4 * i + lr) * N + n0 + 4 * lc); }
#pragma unroll
        for (int pp = 0; pp < 4; ++pp) { const int n = 16 * pp + (lane >> 2), c = lane & 3; const float* s2 = scr + (16 * c) * 65 + n;
            u32x4 o; o.x = pk4f8(s2[0 * 65] * WSCALE, s2[1 * 65] * WSCALE, s2[2 * 65] * WSCALE, s2[3 * 65] * WSCALE); o.y = pk4f8(s2[4 * 65] * WSCALE, s2[5 * 65] * WSCALE, s2[6 * 65] * WSCALE, s2[7 * 65] * WSCALE);
            o.z = pk4f8(s2[8 * 65] * WSCALE, s2[9 * 65] * WSCALE, s2[10 * 65] * WSCALE, s2[11 * 65] * WSCALE); o.w = pk4f8(s2[12 * 65] * WSCALE, s2[13 * 65] * WSCALE, s2[14 * 65] * WSCALE, s2[15 * 65] * WSCALE);
            *(u32x4*)(WTc + (size_t)(n0c + n) * Kc + k0c + 16 * c) = o; }
        asm volatile("s_waitcnt lgkmcnt(0)" ::: "memory");
    }
#undef CV_DECODE
}
__device__ __forceinline__ void convert_small_weights(const P& p, char* smem) {
    const int lane = tid_() & 63, wid = tid_() >> 6, gw = blockIdx.x * NWAVE + wid, ngw = gridDim.x * NWAVE;
    float* scr = (float*)smem + wid * (64 * 33);
    constexpr int I1 = 16 * 96, I2 = 16 * 32, I3 = 16 * 97, I4 = 16 * 32;
    for (int it = gw; it < I1 + I2 + I3 + I4; it += ngw) {
        int r = it;
        if (r < I1) { if (QKV_FP8) transpose_item8(p.na_wqkv, D, 3 * D, p.Wqkv8, 0, scr, r, lane); else transpose_item(p.na_wqkv, D, 3 * D, p.Wqkv_t, 0, scr, r, lane); continue; } r -= I1;
        if (r < I2) { transpose_item(p.na_wout, D, D, p.Wo0_t, 0, scr, r, lane); continue; } r -= I2;
        if (r < I3) { if (MLIN_FP8) transpose_item8(p.ml_win, D, MLW, p.Win8, 0, scr, r, lane); else transpose_item(p.ml_win, D, MLW, p.Win_t, 0, scr, r, lane); continue; } r -= I3;
        transpose_item(p.ml_wout, D, D, p.Wo1_t, 0, scr, r, lane);
    }
}

__host__ __device__ constexpr unsigned long long attn_mask(int hf, int jb, int j) {
    unsigned long long m = 0ull;
    for (int l = 0; l < 64; ++l) { const int g = l >> 4, c = l & 15, qc = 16 * jb + c; int wc0 = qc - 8; wc0 = wc0 < 0 ? 0 : (wc0 > 48 ? 48 : wc0); const int kc = hf * 32 + 8 * g + j;
        if (kc >= wc0 && kc < wc0 + 16) m |= (1ull << l); }
    return m;
}
__device__ __forceinline__ float amax2(float a, float b) { float r; asm("v_max_f32_e32 %0, %1, %2" : "=v"(r) : "v"(a), "v"(b)); return r; }
__device__ __forceinline__ float amax3(float a, float b, float c) { float r; asm("v_max3_f32 %0, %1, %2, %3" : "=v"(r) : "v"(a), "v"(b), "v"(c)); return r; }
__device__ __forceinline__ float sel_mask(float neg, float val, unsigned long long m) { float r; asm("v_cndmask_b32_e64 %0, %1, %2, %3" : "=v"(r) : "v"(neg), "v"(val), "s"(m)); return r; }
__device__ __forceinline__ float x16_amax(float v) { auto r = __builtin_amdgcn_permlane16_swap(__float_as_uint(v), __float_as_uint(v), false, false); return amax2(__uint_as_float(r[0]), __uint_as_float(r[1])); }
__device__ __forceinline__ float x32_amax(float v) { auto r = __builtin_amdgcn_permlane32_swap(__float_as_uint(v), __float_as_uint(v), false, false); return amax2(__uint_as_float(r[0]), __uint_as_float(r[1])); }

#define ATT_THR 16.f
#define ATT_SOFTMAX_PV(jb, vf, force) do { \
        float mx = __builtin_fmaxf(__builtin_fmaxf(sv[0], sv[1]), sv[2]); mx = __builtin_fmaxf(__builtin_fmaxf(mx, sv[3]), sv[4]); mx = __builtin_fmaxf(__builtin_fmaxf(mx, sv[5]), sv[6]); mx = __builtin_fmaxf(mx, sv[7]); \
        if ((force) || __any(mx > ATT_THR)) { mx = x16_amax(mx); mx = x32_amax(mx); const float dl = (force) ? mx : fmaxf(mx, 0.f); const float alpha = __builtin_amdgcn_exp2f(-dl);        \
            const float nm = negm[jb][0] - dl; negm[jb] = (f32x4){nm, nm, nm, nm}; \
            _Pragma("unroll") for (int j = 0; j < 8; ++j) sv[j] -= dl; \
            OL[jb] = OL[jb] * alpha; _Pragma("unroll") for (int dt = 0; dt < 4; ++dt) O[jb][dt] = O[jb][dt] * alpha; } \
        _Pragma("unroll") for (int j = 0; j < 8; ++j) sv[j] = __builtin_amdgcn_exp2f(sv[j]); \
        const bf16x8 pf = pack8(sv); \
        _Pragma("unroll") for (int dt = 0; dt < 4; ++dt) O[jb][dt] = MFMA16(vf[dt], pf, O[jb][dt]); \
        OL[jb] = MFMA16(onesf, pf, OL[jb]); } while (0)
#define ATT_QK(i_, kf) do { f32x4 s0, s1;        \
        s0 = MFMA16(kf[0][0], qf[i_][0], negm[i_]); s0 = MFMA16(kf[0][1], qf[i_][1], s0); s1 = MFMA16(kf[1][0], qf[i_][0], negm[i_]); s1 = MFMA16(kf[1][1], qf[i_][1], s1); \
        _Pragma("unroll") for (int ii = 0; ii < 4; ++ii) { sv[ii] = s0[ii]; sv[4 + ii] = s1[ii]; } } while (0)
#define ATT_LOADKV(kr0, kf, vf) do { const int kk = (kr0) + 8 * (c >> 2) + (c & 3); \
        _Pragma("unroll") for (int tt = 0; tt < 2; ++tt) _Pragma("unroll") for (int ks = 0; ks < 2; ++ks) kf[tt][ks] = *(const bf16x8*)(p.k + (size_t)(kk + 4 * tt) * D + h * 64 + ks * 32 + 8 * g); \
        _Pragma("unroll") for (int dt = 0; dt < 4; ++dt) vf[dt] = *(const bf16x8*)(p.vT + (size_t)(h * 64 + 16 * dt + c) * R + (kr0) + 8 * g); } while (0)

__device__ __forceinline__ void phase_attn(const P& p, char* smem) {
    const int tid = tid_(), lane = tid & 63, g = lane >> 4, c = lane & 15, wid = tid >> 6;
    const int gw = blockIdx.x * NWAVE + wid, ngw = gridDim.x * NWAVE;
    const int jb = __builtin_amdgcn_readfirstlane(wid & 3), rh = __builtin_amdgcn_readfirstlane(wid >> 2);
    float* relw = (float*)smem + wid * 576;
    bf16_t* KC = (bf16_t*)(smem + 18432); bf16_t* VC = KC + 256 * 72;
    bf16_t* RING = VC + 64 * 264;
    constexpr int SLOT = 2 * 64 * 72;
    for (int i = lane; i < 576; i += 64) relw[i] = 0.f;
    const int kc0 = jb == 0 ? 0 : (jb == 1 ? 8 : (jb == 2 ? 24 : 32));
    unsigned long long wm[8];
#pragma unroll
    for (int j = 0; j < 8; ++j) { const int qc = 16 * jb + c; const int wc0 = min(max(qc - 8, 0), 48); const int kc = kc0 + 8 * g + j; wm[j] = __ballot(kc >= wc0 && kc < wc0 + 16); }
    const unsigned one2 = (c == 0) ? 0x3f803f80u : 0u; const u32x4 one4 = {one2, one2, one2, one2}; const bf16x8 onesf = __builtin_bit_cast(bf16x8, one4);
    const int boff = kc0 - 16 * jb + 8 * g - c + 15;
    int hcur = -1;
    for (int wt = blockIdx.x; wt < NB * 16 * 8; wt += gridDim.x) {
        const int b = wt >> 7, h = (wt >> 3) & 15, R0 = (wt & 7) * 8;
        if (h != hcur) { asm volatile("s_waitcnt lgkmcnt(0)" ::: "memory");
            for (int i = lane; i < 465; i += 64) relw[48 + i] = p.na_relb[h * 465 + i] * 1.4426950408889634f;
            asm volatile("s_waitcnt lgkmcnt(0)" ::: "memory"); hcur = h; }
        const int ctx0 = NL + b * CT;
        const int rlo = min(max(R0 - 4, 0), 56), rhi = min(max(R0 + 3, 0), 56) + 8, nrow = rhi - rlo;
        const int skey = tid >> 3, sch = tid & 7;
        const bf16_t* ksrc = p.k + (size_t)(b * T + skey) * D + h * 64 + sch * 8;
        const bf16_t* vsrc = p.vT + (size_t)(h * 64 + skey) * R + b * T + sch * 8;
        __syncthreads();
        { const int key = tid >> 1, hh = tid & 1; const bf16_t* kcs = p.k + (size_t)(ctx0 + key) * D + h * 64 + hh * 32;
          const int dd = tid >> 3, seg = tid & 7; const bf16_t* vcs = p.vT + (size_t)(h * 64 + dd) * R + ctx0 + seg * 32;
          u32x4 kk[4], vv[4];
#pragma unroll
          for (int i = 0; i < 4; ++i) { kk[i] = *(const u32x4*)(kcs + 8 * i); vv[i] = *(const u32x4*)(vcs + 8 * i); }
          const u32x4 k0 = *(const u32x4*)(ksrc + (size_t)rlo * 64 * D), v0 = *(const u32x4*)(vsrc + rlo * 64);
#pragma unroll
          for (int i = 0; i < 4; ++i) { *(u32x4*)(KC + key * 72 + hh * 32 + 8 * i) = kk[i]; *(u32x4*)(VC + dd * 264 + seg * 32 + 8 * i) = vv[i]; }
          *(u32x4*)(RING + skey * 72 + sch * 8) = k0; *(u32x4*)(RING + 64 * 72 + skey * 72 + sch * 8) = v0; }
        __syncthreads();
        bf16x8 qf[4][2];
#pragma unroll
        for (int i = 0; i < 4; ++i)
#pragma unroll
            for (int ks = 0; ks < 2; ++ks) qf[i][ks] = *(const bf16x8*)(p.q + (size_t)(b * T + (R0 + 4 * rh + i) * 64 + 16 * jb + c) * D + h * 64 + ks * 32 + 8 * g);
        f32x4 O[4][4], OL[4], negm[4];
#pragma unroll
        for (int i = 0; i < 4; ++i) { negm[i] = (f32x4){0.f, 0.f, 0.f, 0.f}; OL[i] = (f32x4){0.f, 0.f, 0.f, 0.f};
#pragma unroll
            for (int dt = 0; dt < 4; ++dt) O[i][dt] = (f32x4){0.f, 0.f, 0.f, 0.f}; }
        bf16x8 kf[2][2], vf[4];
#pragma unroll 1
        for (int st = 0; st < 8; ++st) {
            { const int kk = st * 32 + 8 * (c >> 2) + (c & 3);
#pragma unroll
              for (int tt = 0; tt < 2; ++tt)
#pragma unroll
                  for (int ks = 0; ks < 2; ++ks) kf[tt][ks] = *(const bf16x8*)(KC + (kk + 4 * tt) * 72 + ks * 32 + 8 * g);
#pragma unroll
              for (int dt = 0; dt < 4; ++dt) vf[dt] = *(const bf16x8*)(VC + (16 * dt + c) * 264 + st * 32 + 8 * g); }
#pragma unroll
            for (int i = 0; i < 4; ++i) { float sv[8]; ATT_QK(i, kf); ATT_SOFTMAX_PV(i, vf, st == 0); }
        }
#pragma unroll 1
        for (int t = 0; t < nrow; ++t) {
            const int rho = rlo + t; const bf16_t* slot = RING + (t & 1) * SLOT;
            u32x4 kn, vn; const bool more = t + 1 < nrow;
            if (more) { kn = *(const u32x4*)(ksrc + (size_t)(rho + 1) * 64 * D); vn = *(const u32x4*)(vsrc + (rho + 1) * 64); }
            { const int kk = kc0 + 8 * (c >> 2) + (c & 3);
#pragma unroll
              for (int tt = 0; tt < 2; ++tt)
#pragma unroll
                  for (int ks = 0; ks < 2; ++ks) kf[tt][ks] = *(const bf16x8*)(slot + (kk + 4 * tt) * 72 + ks * 32 + 8 * g);
#pragma unroll
              for (int dt = 0; dt < 4; ++dt) vf[dt] = *(const bf16x8*)(slot + 64 * 72 + (16 * dt + c) * 72 + kc0 + 8 * g); }
#pragma unroll
            for (int i = 0; i < 4; ++i) {
                const int r = R0 + 4 * rh + i, r0 = min(max(r - 4, 0), 56);
                if (rho >= r0 && rho < r0 + 8) {
                    const float* rb = relw + 48 + (rho - r + 7) * 31 + boff;
                    float sv[8]; ATT_QK(i, kf);
#pragma unroll
                    for (int j = 0; j < 8; ++j) sv[j] = sel_mask(-1e30f, sv[j] + rb[j], wm[j]);
                    ATT_SOFTMAX_PV(i, vf, false);
                }
            }
            if (more) { bf16_t* nslot = RING + ((t + 1) & 1) * SLOT; *(u32x4*)(nslot + skey * 72 + sch * 8) = kn; *(u32x4*)(nslot + 64 * 72 + skey * 72 + sch * 8) = vn; }
            __syncthreads();
        }
#pragma unroll
        for (int i = 0; i < 4; ++i) { const float il = 1.f / __shfl(OL[i][0], c);
#pragma unroll
            for (int dt = 0; dt < 4; ++dt) st4bf(p.o + (size_t)(b * T + (R0 + 4 * rh + i) * 64 + 16 * jb + c) * D + h * 64 + 16 * dt + 4 * g, O[i][dt] * il); }
    }
    for (int t2 = gw; t2 < NB * 16 * 16; t2 += ngw) {
        const int b = t2 >> 8, h = (t2 >> 4) & 15, qrow0 = NL + b * CT + (t2 & 15) * 16, ctx0 = NL + b * CT;
        bf16x8 qf[1][2];
#pragma unroll
        for (int ks = 0; ks < 2; ++ks) qf[0][ks] = *(const bf16x8*)(p.q + (size_t)(qrow0 + c) * D + h * 64 + ks * 32 + 8 * g);
        f32x4 O[1][4], OL[1], negm[1];
        negm[0] = (f32x4){0.f, 0.f, 0.f, 0.f}; OL[0] = (f32x4){0.f, 0.f, 0.f, 0.f};
#pragma unroll
        for (int dt = 0; dt < 4; ++dt) O[0][dt] = (f32x4){0.f, 0.f, 0.f, 0.f};
        bf16x8 kfA[2][2], vfA[4], kfB[2][2], vfB[4];
        ATT_LOADKV(ctx0, kfA, vfA);
        for (int st = 0; st < 8; st += 2) {
            ATT_LOADKV(ctx0 + (st + 1) * 32, kfB, vfB);
            { float sv[8]; ATT_QK(0, kfA); ATT_SOFTMAX_PV(0, vfA, st == 0); }
            { const int nx = (st + 2 < 8) ? ctx0 + (st + 2) * 32 : ctx0; ATT_LOADKV(nx, kfA, vfA); }
            { float sv[8]; ATT_QK(0, kfB); ATT_SOFTMAX_PV(0, vfB, false); }
        }
        const float il = 1.f / __shfl(OL[0][0], c);
#pragma unroll
        for (int dt = 0; dt < 4; ++dt) st4bf(p.o + (size_t)(qrow0 + c) * D + h * 64 + 16 * dt + 4 * g, O[0][dt] * il);
    }
}
#undef ATT_SOFTMAX_PV
#undef ATT_THR
#undef ATT_QK
#undef ATT_LOADKV

template <int l> __device__ __forceinline__ void phase_post_mixer(const P& p, char* smem) {
    float* wr = (float*)smem;
    for (int idx = tid_(); idx < 1024 * 16 / 4; idx += NTHR) { const int k = idx >> 2, e4 = idx & 3; ((f32x4*)wr)[((k & 3) * 4 + e4) * 256 + (k >> 2)] = ((const f32x4*)(p.moe_wr + (size_t)l * 1024 * 16))[idx]; }
    __syncthreads();
    const int lane = tid_() & 63, gw = blockIdx.x * NWAVE + (tid_() >> 6), ngw = gridDim.x * NWAVE;
    const int nrow = l == 0 ? R : NL; const int npw = (nrow + ngw - 1) / ngw;
    f32x4 g1v[4], g2v[4], gtv[4], shv[4], scv[4];
#pragma unroll
    for (int j = 0; j < 4; ++j) { g1v[j] = ((const f32x4*)(p.norm_g + (l * 4 + 1) * D))[lane + 64 * j]; g2v[j] = ((const f32x4*)(p.norm_g + (l * 4 + 2) * D))[lane + 64 * j]; }
    int scur = -1;
    int row = gw * npw; const int rend = min(nrow, row + npw);
    const unsigned wra = (unsigned)(size_t)(LAS char*)smem + lane * 16;
#define PM_XIN(r) ((r) < NL ? p.x + (size_t)(r) * D : p.ctx + (size_t)((r) - NL) * D)
    while (row < rend) {
        const int s = row < NL ? (row >> 12) : 8;
        const bool two = (row + 1 < rend) && (((row + 1) < NL ? ((row + 1) >> 12) : 8) == s);
        const int row1 = two ? row + 1 : row;
        const int rr[2] = {row, row1};
        u32x2 yw[2][4]; f32x4 xv[2][4];
#pragma unroll
        for (int r = 0; r < 2; ++r)
#pragma unroll
            for (int j = 0; j < 4; ++j) { yw[r][j] = ((const u32x2*)(p.y + (size_t)rr[r] * D))[lane + 64 * j];
                if (l == 0) xv[r][j] = ((const f32x4*)PM_XIN(rr[r]))[lane + 64 * j];
                else { const u32x2 w = ((const u32x2*)(p.xs + (size_t)rr[r] * D))[lane + 64 * j]; xv[r][j] = (f32x4){bflo(w.x), bfhi(w.x), bflo(w.y), bfhi(w.y)}; } }
        if (s != scur) { const float* md = p.mod + (size_t)(l * 9 + s) * 6144; scur = s;
#pragma unroll
            for (int j = 0; j < 4; ++j) { gtv[j] = ((const f32x4*)(md + 2048))[lane + 64 * j]; shv[j] = ((const f32x4*)(md + 3072))[lane + 64 * j]; scv[j] = ((const f32x4*)(md + 4096))[lane + 64 * j]; } }
        f32x4 yv[2][4]; float ss[2] = {0.f, 0.f};
#pragma unroll
        for (int r = 0; r < 2; ++r)
#pragma unroll
            for (int j = 0; j < 4; ++j) { const u32x2 w = yw[r][j]; yv[r][j] = (f32x4){bflo(w.x), bfhi(w.x), bflo(w.y), bfhi(w.y)};
                ss[r] += yv[r][j].x * yv[r][j].x + yv[r][j].y * yv[r][j].y + yv[r][j].z * yv[r][j].z + yv[r][j].w * yv[r][j].w; }
        ss[0] = row_sum16(ss[0]); ss[1] = row_sum16(ss[1]); ss[0] = x16_sum(ss[0]); ss[1] = x16_sum(ss[1]); ss[0] = x32_sum(ss[0]); ss[1] = x32_sum(ss[1]);
        float rs[2], s2[2] = {0.f, 0.f};
#pragma unroll
        for (int r = 0; r < 2; ++r) rs[r] = 1.f / sqrtf(ss[r] * (1.f / D) + EPS);
#pragma unroll
        for (int r = 0; r < 2; ++r) { bf16_t* xo = (p.dry ? (bf16_t*)p.dryx : p.xs) + (size_t)rr[r] * D;
#pragma unroll
            for (int j = 0; j < 4; ++j) { const int ci = lane + 64 * j;
                xv[r][j] = xv[r][j] + gtv[j] * (yv[r][j] * rs[r] * g1v[j]); { u32x2 w; w.x = pk2(xv[r][j].x, xv[r][j].y); w.y = pk2(xv[r][j].z, xv[r][j].w); ((u32x2*)xo)[ci] = w; }
                s2[r] += xv[r][j].x * xv[r][j].x + xv[r][j].y * xv[r][j].y + xv[r][j].z * xv[r][j].z + xv[r][j].w * xv[r][j].w; } }
        s2[0] = row_sum16(s2[0]); s2[1] = row_sum16(s2[1]); s2[0] = x16_sum(s2[0]); s2[1] = x16_sum(s2[1]); s2[0] = x32_sum(s2[0]); s2[1] = x32_sum(s2[1]);
        float rs2[2];
#pragma unroll
        for (int r = 0; r < 2; ++r) rs2[r] = 1.f / sqrtf(s2[r] * (1.f / D) + EPS);
        float lg[2][16];
#pragma unroll
        for (int r = 0; r < 2; ++r)
#pragma unroll
            for (int e = 0; e < 16; ++e) lg[r][e] = 0.f;
#pragma unroll
        for (int j = 0; j < 4; ++j) { const int ci = lane + 64 * j;
#pragma unroll
            for (int r = 0; r < 2; ++r) { xv[r][j] = xv[r][j] * rs2[r] * g2v[j] * (scv[j] + 1.f) + shv[j];
                ((unsigned*)(p.h28 + (size_t)rr[r] * D))[ci] = pk4f8(xv[r][j].x, xv[r][j].y, xv[r][j].z, xv[r][j].w); } }
        {
            f32x4 wb[2][8];
#define PM_RD(buf, g) _Pragma("unroll") for (int q = 0; q < 8; ++q) asm volatile("ds_read_b128 %0, %1 offset:%2" : "=v"(wb[buf][q]) : "v"(wra), "n"(((((g) & 1) * 2 + (q >> 2)) * 4 + (q & 3)) * 4096 + ((g) >> 1) * 1024))
#define PM_WAIT(buf, n) asm volatile("s_waitcnt lgkmcnt(" #n ")" : "+v"(wb[buf][0]), "+v"(wb[buf][1]), "+v"(wb[buf][2]), "+v"(wb[buf][3]), "+v"(wb[buf][4]), "+v"(wb[buf][5]), "+v"(wb[buf][6]), "+v"(wb[buf][7]))
#define PM_FMA(buf, g) _Pragma("unroll") for (int q = 0; q < 8; ++q) { const int i_ = ((g) & 1) * 2 + (q >> 2), e4_ = q & 3; const f32x4 wv = wb[buf][q]; \
                _Pragma("unroll") for (int r = 0; r < 2; ++r) { const float hx = xv[r][(g) >> 1][i_]; lg[r][4 * e4_] += hx * wv.x; lg[r][4 * e4_ + 1] += hx * wv.y; lg[r][4 * e4_ + 2] += hx * wv.z; lg[r][4 * e4_ + 3] += hx * wv.w; } }
            PM_RD(0, 0);
            PM_RD(1, 1); PM_WAIT(0, 8); PM_FMA(0, 0);
            PM_RD(0, 2); PM_WAIT(1, 8); PM_FMA(1, 1);
            PM_RD(1, 3); PM_WAIT(0, 8); PM_FMA(0, 2);
            PM_RD(0, 4); PM_WAIT(1, 8); PM_FMA(1, 3);
            PM_RD(1, 5); PM_WAIT(0, 8); PM_FMA(0, 4);
            PM_RD(0, 6); PM_WAIT(1, 8); PM_FMA(1, 5);
            PM_RD(1, 7); PM_WAIT(0, 8); PM_FMA(0, 6);
            PM_WAIT(1, 0); PM_FMA(1, 7);
#undef PM_RD
#undef PM_WAIT
#undef PM_FMA
        }
        float r1[2];
#pragma unroll
        for (int r = 0; r < 2; ++r) { float r8[8], r4[4], r2[2];
#pragma unroll
            for (int e = 0; e < 8; ++e) { auto q2 = __builtin_amdgcn_permlane32_swap(__float_as_uint(lg[r][e]), __float_as_uint(lg[r][e + 8]), false, false); r8[e] = __uint_as_float(q2[0]) + __uint_as_float(q2[1]); }
#pragma unroll
            for (int e = 0; e < 4; ++e) { auto q2 = __builtin_amdgcn_permlane16_swap(__float_as_uint(r8[e]), __float_as_uint(r8[e + 4]), false, false); r4[e] = __uint_as_float(q2[0]) + __uint_as_float(q2[1]); }
            { const bool hi = lane & 8;
#pragma unroll
              for (int e = 0; e < 2; ++e) { const float keep = hi ? r4[e + 2] : r4[e], send = hi ? r4[e] : r4[e + 2]; r2[e] = keep + dpp_<0x128>(send); } }
            { const bool hi = lane & 4; const float keep = hi ? r2[1] : r2[0], send = hi ? r2[0] : r2[1]; r1[r] = keep + __shfl_xor(send, 4); }
            r1[r] += dpp_<0xB1>(r1[r]); r1[r] += dpp_<0x4E>(r1[r]); }
        const int eidx = ((lane >> 5) & 1) * 8 + ((lane >> 4) & 1) * 4 + ((lane >> 3) & 1) * 2 + ((lane >> 2) & 1);
#pragma unroll
        for (int r = 0; r < 2; ++r) { float mx = r1[r];
            mx = fmaxf(mx, dpp_<0x124>(mx)); mx = fmaxf(mx, dpp_<0x128>(mx)); mx = x16_max(mx); mx = x32_max(mx);
            const float ex = __expf(r1[r] - mx); float sum = ex;
            sum += dpp_<0x124>(sum); sum += dpp_<0x128>(sum); sum = x16_sum(sum); sum = x32_sum(sum);
            if ((lane & 3) == 0) p.aff[(size_t)rr[r] * 16 + eidx] = ex / sum; }
        row += two ? 2 : 1;
    }
#undef PM_XIN
}

__device__ __forceinline__ void phase_topk(const P& p, int l, char* smem) {
    unsigned* key = (unsigned*)smem;
    unsigned* cntw = key + 4096;
    int* wsum = (int*)(cntw + 16);
    int* rowsel = wsum + 16;
    const int tid = tid_(), lane = tid & 63, wid = tid >> 6;
    const int nset = l == 0 ? 16 : 8;
    const int cap_tot = l == 0 ? CAP0 : CAP1;
    for (int task = blockIdx.x; task < nset * NE; task += gridDim.x) {
        const int set = task / NE, e = task % NE;
        const bool lat = set < 8; const int n = lat ? T : CT, cap = lat ? CAPL : CAPC;
        const int row0 = lat ? set * T : NL + (set - 8) * CT;
        const int slot0 = lat ? set * CAPL : NB * CAPL + (set - 8) * CAPC;
        for (int i = tid; i < n; i += NTHR) key[i] = __float_as_uint(p.aff[(size_t)(row0 + i) * 16 + e]);
        __syncthreads();
        unsigned Tv = 0u;
        for (int bit = 30; bit >= 0; --bit) {
            const unsigned cand = Tv | (1u << bit); int cnt = 0;
            for (int i = tid; i < n; i += NTHR) cnt += (key[i] >= cand) ? 1 : 0;
            cnt = (int)wave_sum((float)cnt);
            if (lane == 0) cntw[wid] = (unsigned)cnt;
            __syncthreads();
            int tot = 0;
#pragma unroll
            for (int w2 = 0; w2 < 8; ++w2) tot += (int)cntw[w2];
            if (tot >= cap) Tv = cand;
            __syncthreads();
        }
        const int per = lat ? 8 : 1; const bool act = lat || tid < CT; const int i0 = tid * per;
        int ngt = 0, neq = 0;
        if (act) for (int j = 0; j < per; ++j) { const unsigned kv = key[i0 + j]; ngt += kv > Tv; neq += kv == Tv; }
        int sg = ngt, se = neq;
#pragma unroll
        for (int o = 1; o < 64; o <<= 1) { const int a = __shfl_up(sg, o), b2 = __shfl_up(se, o); if (lane >= o) { sg += a; se += b2; } }
        if (lane == 63) { wsum[wid] = sg; wsum[8 + wid] = se; }
        __syncthreads();
        int og = 0, oe = 0, totg = 0;
#pragma unroll
        for (int w2 = 0; w2 < 8; ++w2) { const int a = wsum[w2], b2 = wsum[8 + w2]; if (w2 < wid) { og += a; oe += b2; } totg += a; }
        int pg = og + sg - ngt, pe = oe + se - neq;
        const int need_eq = cap - totg;
        if (act) for (int j = 0; j < per; ++j) {
            const unsigned kv = key[i0 + j]; const int row = row0 + i0 + j; int slot = -1;
            if (kv > Tv) { slot = pg + min(pe, need_eq); ++pg; }
            else if (kv == Tv) { if (pe < need_eq) slot = pg + pe; ++pe; }
            p.inv[(size_t)row * 16 + e] = slot >= 0 ? slot0 + slot : -1;
            if (slot >= 0) { rowsel[slot] = row; p.list[e * CAP0 + slot0 + slot] = row; p.gatev[e * CAP0 + slot0 + slot] = __uint_as_float(kv); }
        }
        __syncthreads();
        __syncthreads();
    }
}

template <int l> __device__ __forceinline__ void phase_post_ffn(const P& p) {
    const int lane = tid_() & 63, gw = blockIdx.x * NWAVE + (tid_() >> 6), ngw = gridDim.x * NWAVE;
    const int nrow = l == 0 ? R : NL; const int cap_tot = l == 0 ? CAP0 : CAP1; const int npw = (nrow + ngw - 1) / ngw;
    f32x4 g3v[4], gnv[4], gtv[4], shv[4], scv[4];
#pragma unroll
    for (int j = 0; j < 4; ++j) { g3v[j] = ((const f32x4*)(p.norm_g + (l * 4 + 3) * D))[lane + 64 * j]; if (l == 0) gnv[j] = ((const f32x4*)(p.norm_g + ((l + 1) * 4 + 0) * D))[lane + 64 * j]; }
    int scur = -1;
    int row = gw * npw; const int rend = min(nrow, row + npw);
#define PF_GATHER(invreg, yd, cnt, rest) do { unsigned long long m_ = __ballot((invreg) >= 0); cnt = 0; \
        _Pragma("unroll") for (int k = 0; k < 4; ++k) { if (m_ != 0ull) { const int e_ = __builtin_ctzll(m_); m_ &= m_ - 1; const int sl_ = __builtin_amdgcn_readlane((invreg), e_); \
            const u32x2* src_ = (const u32x2*)(p.XgY + ((size_t)e_ * cap_tot + sl_) * D); _Pragma("unroll") for (int j = 0; j < 4; ++j) yd[k][j] = src_[lane + 64 * j]; cnt = k + 1; } } \
        rest = m_; } while (0)
    u32x2 xr[4], yr[4][4]; int ycnt = 0; unsigned long long yrest = 0ull; int invc = -1, invn = -1;
    if (row < rend) { invc = (lane < 16) ? p.inv[(size_t)row * 16 + lane] : -1;
        if (row + 1 < rend) invn = (lane < 16) ? p.inv[(size_t)(row + 1) * 16 + lane] : -1;
#pragma unroll
        for (int j = 0; j < 4; ++j) xr[j] = ((const u32x2*)(p.xs + (size_t)row * D))[lane + 64 * j];
        PF_GATHER(invc, yr, ycnt, yrest); }
    for (; row < rend; ++row) {
        u32x2 xrn[4], yrn[4][4]; int ycntn = 0; unsigned long long yrestn = 0ull; int invnn = -1;
        const bool hn = row + 1 < rend;
        if (hn) {
#pragma unroll
            for (int j = 0; j < 4; ++j) xrn[j] = ((const u32x2*)(p.xs + (size_t)(row + 1) * D))[lane + 64 * j];
            PF_GATHER(invn, yrn, ycntn, yrestn);
            if (row + 2 < rend) invnn = (lane < 16) ? p.inv[(size_t)(row + 2) * 16 + lane] : -1; }
        f32x4 mv[4], xv[4];
#pragma unroll
        for (int j = 0; j < 4; ++j) mv[j] = (f32x4){0.f, 0.f, 0.f, 0.f};
#pragma unroll
        for (int k = 0; k < 4; ++k) if (k < ycnt) {
#pragma unroll
            for (int j = 0; j < 4; ++j) { const u32x2 w = yr[k][j]; mv[j] += (f32x4){bflo(w.x), bfhi(w.x), bflo(w.y), bfhi(w.y)}; } }
        while (yrest) {
            const int e = __builtin_ctzll(yrest); yrest &= yrest - 1; const int sl = __builtin_amdgcn_readlane(invc, e);
            const u32x2* src = (const u32x2*)(p.XgY + ((size_t)e * cap_tot + sl) * D);
#pragma unroll
            for (int j = 0; j < 4; ++j) { const u32x2 w = src[lane + 64 * j]; mv[j] += (f32x4){bflo(w.x), bfhi(w.x), bflo(w.y), bfhi(w.y)}; } }
#pragma unroll
        for (int j = 0; j < 4; ++j) xv[j] = (f32x4){bflo(xr[j].x), bfhi(xr[j].x), bflo(xr[j].y), bfhi(xr[j].y)};
        const int s = row < NL ? (row >> 12) : 8;
        if (s != scur) { const float* md = p.mod + (size_t)(l * 9 + s) * 6144; const float* md1 = p.mod + (size_t)(1 * 9 + s) * 6144; scur = s;
#pragma unroll
            for (int j = 0; j < 4; ++j) { gtv[j] = ((const f32x4*)(md + 5120))[lane + 64 * j]; if (l == 0) { shv[j] = ((const f32x4*)md1)[lane + 64 * j]; scv[j] = ((const f32x4*)(md1 + 1024))[lane + 64 * j]; } } }
        float ss = 0.f;
#pragma unroll
        for (int j = 0; j < 4; ++j) ss += mv[j].x * mv[j].x + mv[j].y * mv[j].y + mv[j].z * mv[j].z + mv[j].w * mv[j].w;
        ss = wave_sum(ss); const float rs = 1.f / sqrtf(ss * (1.f / D) + EPS);
        float s2 = 0.f;
#pragma unroll
        for (int j = 0; j < 4; ++j) { const int ci = lane + 64 * j;
            xv[j] = xv[j] + gtv[j] * (mv[j] * rs * g3v[j]);
            if (l == 0) { u32x2 w; w.x = pk2(xv[j].x, xv[j].y); w.y = pk2(xv[j].z, xv[j].w); ((u32x2*)((p.dry ? (bf16_t*)p.dryx : p.xs) + (size_t)row * D))[ci] = w; }
            else ((f32x4*)((p.dry ? p.dryx : p.out) + (size_t)row * D))[ci] = xv[j];
            s2 += xv[j].x * xv[j].x + xv[j].y * xv[j].y + xv[j].z * xv[j].z + xv[j].w * xv[j].w; }
        if (l == 0) {
            s2 = wave_sum(s2); const float rs2 = 1.f / sqrtf(s2 * (1.f / D) + EPS);
#pragma unroll
            for (int j = 0; j < 4; ++j) { const int ci = lane + 64 * j;
                const f32x4 hv = xv[j] * rs2 * gnv[j] * (scv[j] + 1.f) + shv[j];
                if (MLIN_FP8) ((unsigned*)(p.h8 + (size_t)row * D))[ci] = pk4f8(hv.x, hv.y, hv.z, hv.w);
                else { u32x2 w; w.x = pk2(hv.x, hv.y); w.y = pk2(hv.z, hv.w); ((u32x2*)(p.h + (size_t)row * D))[ci] = w; } }
        }
        if (hn) { invc = invn; invn = invnn; ycnt = ycntn; yrest = yrestn;
#pragma unroll
            for (int j = 0; j < 4; ++j) { xr[j] = xrn[j];
#pragma unroll
                for (int k = 0; k < 4; ++k) yr[k][j] = yrn[k][j]; } }
    }
#undef PF_GATHER
}

constexpr int IST = 72;
constexpr int IMG_Q = 0, IMG_K = 64 * IST, IMG_KT = 2 * 64 * IST, IMG_VT = 3 * 64 * IST, IMG_ELEMS = 4 * 64 * IST;
constexpr int CT_ROWS = 80;
__device__ __forceinline__ int tswz(int row, int blk) { return ((blk ^ ((row >> 3) & 7)) << 3); }
__device__ __forceinline__ void phase_mscan(const P& p, char* smem) {
    bf16_t* img = (bf16_t*)smem;
    bf16_t* SG = img + 2 * IMG_ELEMS;
    bf16_t* CTi = SG + 64 * IST;
    float* scal = (float*)(CTi + 2 * CT_ROWS * IST);
    float* decs = scal + 2 * 5 * 64;
    const int tid = tid_(), lane = tid & 63, wid = tid >> 6, g0_ = lane >> 4, c0_ = lane & 15;
    for (int task = blockIdx.x; task < NB * 16 * 2; task += gridDim.x) {
        const int b = task >> 5, G = (task >> 1) & 15, vh = task & 1, dir = G >> 3, head = G & 7;
        bf16_t* hout = dir ? p.hb : p.hf;
        for (int i = tid; i < 2 * CT_ROWS * IST; i += NTHR) CTi[i] = 0;
        f32x4 accC[4];
#pragma unroll
        for (int tc = 0; tc < 4; ++tc) accC[tc] = (f32x4){0.f, 0.f, 0.f, 0.f};
        float nreg = 0.f, mstate = -1e30f;
        u32x4 sq0[2], sk0[2], sv0[2];
        auto rowof = [&](int cc, int j) -> int { const bool isc = cc < 4; const int Tn = isc ? CT : T; const int pp = (isc ? cc : cc - 4) * 64 + j; const int t = dir ? Tn - 1 - pp : pp; return (isc ? NL + b * CT : b * T) + t; };
#define MS_LOAD(cc, stq, stk, stv) do { _Pragma("unroll") for (int u = 0; u < 2; ++u) { const int pc = (tidl - 256) + 256 * u; const int j = pc >> 3, ch = pc & 7; const size_t row = (size_t)rowof(cc, j); \
            stq[u] = *(const u32x4*)(p.qm + row * 512 + head * 64 + ch * 8); stk[u] = *(const u32x4*)(p.km + row * 512 + head * 64 + ch * 8); \
            stv[u] = *(const u32x4*)(p.vm + row * D + head * 128 + vh * 64 + ch * 8); } } while (0)
#define MS_STORE(buf, stq, stk, stv) do { bf16_t* im = img + (buf) * IMG_ELEMS; _Pragma("unroll") for (int u = 0; u < 2; ++u) { const int pc = (tidl - 256) + 256 * u; const int j = pc >> 3, ch = pc & 7; \
            *(u32x4*)(im + IMG_Q + j * IST + ch * 8) = stq[u]; *(u32x4*)(im + IMG_K + j * IST + ch * 8) = stk[u]; \
            const unsigned kw[4] = {stk[u].x, stk[u].y, stk[u].z, stk[u].w}; const unsigned vw[4] = {stv[u].x, stv[u].y, stv[u].z, stv[u].w}; \
            _Pragma("unroll") for (int e2 = 0; e2 < 4; ++e2) { im[IMG_KT + (ch * 8 + 2 * e2) * IST + tswz(ch * 8, j >> 3) + (j & 7)] = (bf16_t)(kw[e2] & 0xffffu); im[IMG_KT + (ch * 8 + 2 * e2 + 1) * IST + tswz(ch * 8, j >> 3) + (j & 7)] = (bf16_t)(kw[e2] >> 16); \
                im[IMG_VT + (ch * 8 + 2 * e2) * IST + tswz(ch * 8, j >> 3) + (j & 7)] = (bf16_t)(vw[e2] & 0xffffu); im[IMG_VT + (ch * 8 + 2 * e2 + 1) * IST + tswz(ch * 8, j >> 3) + (j & 7)] = (bf16_t)(vw[e2] >> 16); } } } while (0)
#define MS_GLOAD(cc, g_ig, g_lf) do { const size_t row = (size_t)rowof(cc, lane); g_ig = p.gates[row * 32 + dir * 8 + head]; g_lf = p.gates[row * 32 + 16 + dir * 8 + head]; } while (0)
#define MS_SCAL(cc, buf, g_ig, g_lf) do { const float ig = g_ig, lf = g_lf; \
            const float bc = wave_scan_add(lf); \
            const float av = ig - bc; const float pm = wave_scan_max(av); \
            const float bend = __uint_as_float((unsigned)__builtin_amdgcn_readlane((int)__float_as_uint(bc), 63)), pm63 = __uint_as_float((unsigned)__builtin_amdgcn_readlane((int)__float_as_uint(pm), 63)); const float mnext = fmaxf(bend + mstate, bend + pm63); const float Mt = fmaxf(pm, mstate); \
            float* sb = scal + (buf) * 5 * 64; sb[lane] = av; sb[64 + lane] = Mt; sb[128 + lane] = __expf(mstate - Mt); sb[192 + lane] = __expf(-(bc + Mt)); sb[256 + lane] = __expf(bend + av - mnext); \
            if (lane == 0) decs[buf] = __expf(bend + mstate - mnext); mstate = mnext; } while (0)
        float gi0 = 0.f, gl0 = 0.f;
        int tidl = tid;
        if (wid >= 4) { MS_LOAD(0, sq0, sk0, sv0); }
        if (wid == 7) { MS_GLOAD(0, gi0, gl0); }
        __syncthreads();
        if (wid >= 4) { MS_STORE(0, sq0, sk0, sv0); MS_LOAD(1, sq0, sk0, sv0); }
        if (wid == 7) { MS_SCAL(0, 0, gi0, gl0); MS_GLOAD(1, gi0, gl0); }
        __syncthreads();
        for (int cc = 0; cc < 68; ++cc) {
            const int cur = cc & 1, nxt = cur ^ 1;
            int c_ = c0_, g_ = g0_; tidl = tid; asm volatile("" : "+v"(c_), "+v"(g_), "+v"(tidl));
            const bf16_t* im = img + cur * IMG_ELEMS; const float* sb = scal + cur * 5 * 64;
            if (wid >= 4) {
                if (cc + 1 < 68) { MS_STORE(nxt, sq0, sk0, sv0); if (wid == 7) { MS_SCAL(cc + 1, nxt, gi0, gl0); } }
                if (cc + 2 < 68) { MS_LOAD(cc + 2, sq0, sk0, sv0); if (wid == 7) { MS_GLOAD(cc + 2, gi0, gl0); } }
                const int wq = wid - 4; const float decay = decs[cur];
#pragma unroll
                for (int tc = 0; tc < 4; ++tc) accC[tc] = accC[tc] * decay;
#pragma unroll
                for (int ks = 0; ks < 2; ++ks) {
                    const u32x4 kraw = *(const u32x4*)(im + IMG_KT + (16 * wq + c_) * IST + tswz(16 * wq + c_, 4 * ks + g_));
                    const f32x4 w0 = *(const f32x4*)(sb + 256 + 32 * ks + 8 * g_), w1 = *(const f32x4*)(sb + 256 + 32 * ks + 8 * g_ + 4);
                    float t8[8] = {bflo(kraw.x) * w0.x, bfhi(kraw.x) * w0.y, bflo(kraw.y) * w0.z, bfhi(kraw.y) * w0.w, bflo(kraw.z) * w1.x, bfhi(kraw.z) * w1.y, bflo(kraw.w) * w1.z, bfhi(kraw.w) * w1.w};
                    const bf16x8 kwf = pack8(t8);
#pragma unroll
                    for (int tc = 0; tc < 4; ++tc) { const bf16x8 vtf = *(const bf16x8*)(im + IMG_VT + (16 * tc + c_) * IST + tswz(16 * tc + c_, 4 * ks + g_)); accC[tc] = MFMA16(kwf, vtf, accC[tc]); }
                }
                bf16_t* ctn = CTi + nxt * CT_ROWS * IST;
#pragma unroll
                for (int tc = 0; tc < 4; ++tc) { u32x2 w; w.x = pk2(accC[tc].x, accC[tc].y); w.y = pk2(accC[tc].z, accC[tc].w); *(u32x2*)(ctn + (16 * tc + c_) * IST + 16 * wq + 4 * g_) = w; }
                if (wid == 4) {
                    float sacc = 0.f;
#pragma unroll
                    for (int s8 = 0; s8 < 8; ++s8) { const u32x4 kr = *(const u32x4*)(im + IMG_KT + lane * IST + tswz(lane, s8)); const f32x4 w0 = *(const f32x4*)(sb + 256 + 8 * s8), w1 = *(const f32x4*)(sb + 256 + 8 * s8 + 4);
                        sacc += bflo(kr.x) * w0.x + bfhi(kr.x) * w0.y + bflo(kr.y) * w0.z + bfhi(kr.y) * w0.w + bflo(kr.z) * w1.x + bfhi(kr.z) * w1.y + bflo(kr.w) * w1.z + bfhi(kr.w) * w1.w; }
                    nreg = nreg * decay + sacc; ctn[64 * IST + lane] = f2bf(nreg);
                }
            } else if (cc >= 4) {
                const int tr = wid; const bf16_t* ctc = CTi + cur * CT_ROWS * IST; const int t = 16 * tr + c_;
                bf16x8 qB[2], kfr[4][2], vtf[4][2], ctf[4][2], nf[2];
#pragma unroll
                for (int ks = 0; ks < 2; ++ks) { qB[ks] = *(const bf16x8*)(im + IMG_Q + t * IST + 32 * ks + 8 * g_); nf[ks] = *(const bf16x8*)(ctc + (64 + c_) * IST + 32 * ks + 8 * g_); }
#pragma unroll
                for (int ts = 0; ts < 4; ++ts)
#pragma unroll
                    for (int ks = 0; ks < 2; ++ks) if (ts <= tr) kfr[ts][ks] = *(const bf16x8*)(im + IMG_K + (16 * ts + c_) * IST + 32 * ks + 8 * g_);
#pragma unroll
                for (int dvt = 0; dvt < 4; ++dvt)
#pragma unroll
                    for (int ks = 0; ks < 2; ++ks) { const int dvr = 16 * dvt + c_;
                        const u32x2 v0 = *(const u32x2*)(im + IMG_VT + dvr * IST + tswz(dvr, 4 * ks + (g_ >> 1)) + 4 * (g_ & 1));
                        const u32x2 v1 = *(const u32x2*)(im + IMG_VT + dvr * IST + tswz(dvr, 4 * ks + 2 + (g_ >> 1)) + 4 * (g_ & 1));
                        u32x4 vw; vw.x = v0.x; vw.y = v0.y; vw.z = v1.x; vw.w = v1.y; vtf[dvt][ks] = __builtin_bit_cast(bf16x8, vw);
                        ctf[dvt][ks] = *(const bf16x8*)(ctc + dvr * IST + 32 * ks + 8 * g_); }
                const float Mt = sb[64 + t], wint = sb[128 + t], en = sb[192 + t];
                f32x4 a4[4];
#pragma unroll
                for (int ts = 0; ts < 4; ++ts) a4[ts] = *(const f32x4*)(sb + 16 * ts + 4 * g_);
                unsigned pb[4][2]; float rsum = 0.f;
#pragma unroll
                for (int ts = 0; ts < 4; ++ts) {
                    pb[ts][0] = 0u; pb[ts][1] = 0u;
                    if (ts <= tr) {
                        f32x4 s0 = (f32x4){0.f, 0.f, 0.f, 0.f};
#pragma unroll
                        for (int ks = 0; ks < 2; ++ks) s0 = MFMA16(kfr[ts][ks], qB[ks], s0);
                        float pv[4];
#pragma unroll
                        for (int i = 0; i < 4; ++i) { const int sidx = 16 * ts + 4 * g_ + i; pv[i] = (sidx <= t) ? s0[i] * __expf(a4[ts][i] - Mt) : 0.f; rsum += pv[i]; }
                        pb[ts][0] = pk2(pv[0], pv[1]); pb[ts][1] = pk2(pv[2], pv[3]);
                    }
                }
                rsum = x16_sum(rsum); rsum = x32_sum(rsum);
                f32x4 qn4 = (f32x4){0.f, 0.f, 0.f, 0.f};
#pragma unroll
                for (int ks = 0; ks < 2; ++ks) qn4 = MFMA16(nf[ks], qB[ks], qn4);
                const float qn = __shfl(qn4[0], c_);
                const float den = rsum + wint * qn; const float inv_den = 1.f / fmaxf(fabsf(den), en);
                bf16x8 pB[2];
#pragma unroll
                for (int ks = 0; ks < 2; ++ks) { u32x4 w; w.x = pb[2 * ks][0]; w.y = pb[2 * ks][1]; w.z = pb[2 * ks + 1][0]; w.w = pb[2 * ks + 1][1]; pB[ks] = __builtin_bit_cast(bf16x8, w); }
                const size_t orow = (size_t)rowof(cc, t);
#pragma unroll
                for (int dvt = 0; dvt < 4; ++dvt) {
                    f32x4 nin = (f32x4){0.f, 0.f, 0.f, 0.f}, nit = nin;
#pragma unroll
                    for (int ks = 0; ks < 2; ++ks) { nit = MFMA16(ctf[dvt][ks], qB[ks], nit); nin = MFMA16(vtf[dvt][ks], pB[ks], nin); }
                    st4bf(hout + orow * D + head * 128 + vh * 64 + 16 * dvt + 4 * g_, (nin + nit * wint) * inv_den);
                }
            }
            asm volatile("s_waitcnt lgkmcnt(0)" ::: "memory"); __builtin_amdgcn_s_barrier(); asm volatile("" ::: "memory");
        }
#undef MS_LOAD
#undef MS_STORE
#undef MS_SCAL
#undef MS_GLOAD
    }
}

__device__ __forceinline__ void phase_readout(const P& p) {
    const int lane = tid_() & 63, gw = blockIdx.x * NWAVE + (tid_() >> 6), ngw = gridDim.x * NWAVE;
    for (int row = gw; row < NL; row += ngw) {
        float hs[16]; float ss = 0.f;
#pragma unroll
        for (int u = 0; u < 2; ++u) { const u32x4 a = ((const u32x4*)(p.hf + (size_t)row * D))[2 * lane + u], b2 = ((const u32x4*)(p.hb + (size_t)row * D))[2 * lane + u];
            const unsigned aw[4] = {a.x, a.y, a.z, a.w}, bw[4] = {b2.x, b2.y, b2.z, b2.w};
#pragma unroll
            for (int e = 0; e < 4; ++e) { const float v0 = bflo(aw[e]) + bflo(bw[e]), v1 = bfhi(aw[e]) + bfhi(bw[e]); hs[8 * u + 2 * e] = v0; hs[8 * u + 2 * e + 1] = v1; ss += v0 * v0 + v1 * v1; } }
        ss += dpp_<0xB1>(ss); ss += dpp_<0x4E>(ss); ss += dpp_<0x141>(ss);
        const float rs = 1.f / sqrtf(ss * (1.f / 128.f) + EPS);
#pragma unroll
        for (int u = 0; u < 2; ++u) { const u32x4 ov = ((const u32x4*)(p.om + (size_t)row * D))[2 * lane + u]; const unsigned ow[4] = {ov.x, ov.y, ov.z, ov.w}; u32x4 w; unsigned wo[4];
#pragma unroll
            for (int e = 0; e < 4; ++e) { const int col = 16 * lane + 8 * u + 2 * e; const float a0 = hs[8 * u + 2 * e] * rs * p.ml_normw[col] * sigmoidf_(bflo(ow[e])), a1 = hs[8 * u + 2 * e + 1] * rs * p.ml_normw[col + 1] * sigmoidf_(bfhi(ow[e])); wo[e] = pk2(a0, a1); }
            w.x = wo[0]; w.y = wo[1]; w.z = wo[2]; w.w = wo[3]; ((u32x4*)(p.ro + (size_t)row * D))[2 * lane + u] = w; }
    }
}


#define XB_TMO      128
#define XB_XCNT(j)  (256  + 64 * (j))
#define XB_XSUB(j)  (1280 + 64 * (j))
#define XB_XGEN(j)  (2304 + 64 * (j))
#define XB_TOP      3328
#define XB_TOPGEN   3392
#define XCD_BAR_WORDS 3456
#define XB_SPIN_CAP (1u << 18)
__device__ __forceinline__ unsigned xb_ld(unsigned* p)              { return __hip_atomic_load(p, __ATOMIC_RELAXED, __HIP_MEMORY_SCOPE_AGENT); }
__device__ __forceinline__ unsigned xb_add(unsigned* p, unsigned v) { return __hip_atomic_fetch_add(p, v, __ATOMIC_RELAXED, __HIP_MEMORY_SCOPE_AGENT); }
__device__ __forceinline__ unsigned xb_xcc_id() { return (unsigned)__builtin_amdgcn_s_getreg((3 << 11) | 20) & 0xFu; }
#define XB_SPIN(cond, bar) do { unsigned _sp = 0; while (cond) { __builtin_amdgcn_s_sleep(1); \
    if ((++_sp & 255u) == 0u) { if (xb_ld(&(bar)[XB_TMO])) break; if (_sp > XB_SPIN_CAP) { atomicAdd(&(bar)[XB_TMO], 1u); break; } } } } while (0)
struct XcdBarrier { unsigned* bar; unsigned x; volatile LAS unsigned* st; };
__device__ __forceinline__ XcdBarrier xcd_barrier_post(unsigned* bar, volatile LAS unsigned* st) {
    XcdBarrier b; b.bar = bar; b.x = xb_xcc_id(); b.st = st;
    if (tid_() == 0) (void)xb_add(&bar[XB_XCNT(b.x)], 1u);
    return b;
}
__device__ __forceinline__ void xcd_barrier_complete(unsigned* bar, unsigned x, unsigned& nloc, unsigned& nx) {
    const unsigned G = gridDim.x * gridDim.y * gridDim.z;
    unsigned sum, cnt, mine, sp = 0u;
    for (;;) {
        sum = 0u; cnt = 0u; mine = 0u;
#pragma unroll
        for (unsigned j = 0; j < 16; ++j) { const unsigned c = xb_ld(&bar[XB_XCNT(j)]); sum += c; cnt += (c > 0u) ? 1u : 0u; mine = (j == x) ? c : mine; }
        if (sum == G) break;
        __builtin_amdgcn_s_sleep(1);
        if ((++sp & 255u) == 0u) { if (xb_ld(&bar[XB_TMO])) break; if (sp > XB_SPIN_CAP) { atomicAdd(&bar[XB_TMO], 1u); break; } }
    }
    nloc = mine > 0u ? mine : 1u; nx = cnt > 0u ? cnt : 1u;
}
__device__ __forceinline__ void xcd_barrier(const XcdBarrier& b) {
    asm volatile("s_waitcnt vmcnt(0)" ::: "memory");
    __syncthreads();
    if (tid_() == 0) {
        unsigned* bar = b.bar;
        __builtin_amdgcn_s_waitcnt(0);
        unsigned nloc = b.st[0], nx = b.st[1];
        if (nloc == 0u) { xcd_barrier_complete(bar, b.x, nloc, nx); b.st[0] = nloc; b.st[1] = nx; }
        const unsigned old = xb_add(&bar[XB_XSUB(b.x)], 1u);
        const unsigned gen = old / nloc;
        if (old + 1u == (gen + 1u) * nloc) {
            __builtin_amdgcn_fence(__ATOMIC_RELEASE, "agent");
            asm volatile("s_waitcnt vmcnt(0)" ::: "memory");
            const unsigned og = xb_add(&bar[XB_TOP], 1u);
            const unsigned tg = og / nx;
            if (og + 1u == (tg + 1u) * nx) xb_add(&bar[XB_TOPGEN], 1u);
            else XB_SPIN(xb_ld(&bar[XB_TOPGEN]) == tg, bar);
            __builtin_amdgcn_fence(__ATOMIC_ACQUIRE, "agent");
            xb_add(&bar[XB_XGEN(b.x)], 1u);
            asm volatile("s_waitcnt vmcnt(0)" ::: "memory");
        } else {
            XB_SPIN(xb_ld(&bar[XB_XGEN(b.x)]) == gen, bar);
            __builtin_amdgcn_fence(__ATOMIC_ACQUIRE, "agent");
            asm volatile("s_waitcnt vmcnt(0)" ::: "memory");
        }
    }
    __syncthreads();
}

constexpr int NPHASE = 19;
__global__ void __launch_bounds__(NTHR, 2) fwd_kernel(P p) {
    extern __shared__ __attribute__((aligned(16))) char smem[];
    cg::grid_group grid = cg::this_grid();
    PG8_LAS unsigned char* LDSP = (PG8_LAS unsigned char*)smem;
    volatile LAS unsigned* bst = (volatile LAS unsigned*)(LDSP + LDS_BYTES - 64);
    if (tid_() < 2) bst[tid_()] = 0u;
    __syncthreads();
    const XcdBarrier xbar = xcd_barrier_post(p.ctl, bst);
    if (p.ph_lo == 0x7fffffff) grid.sync();
#define GSYNC(k) do { xcd_barrier(xbar); } while (0)
#define CVFILL(base, limit, first_cu) convert_moe_fill(p, (float*)(smem + 20480) + (tid_() >> 6) * (64 * 65), (base), (limit), (first_cu))
    for (int i = 0; i < EXTRA_SYNCS; ++i) GSYNC(1);
    if (p.ph_lo <= 0 && 0 < p.ph_hi) { phase_mod(p, smem); __syncthreads(); convert_small_weights(p, smem); if (0 + 1 < p.ph_hi) GSYNC(0); }
    if (p.ph_lo <= 1 && 1 < p.ph_hi) { phase_norm0(p); if (1 + 1 < p.ph_hi) GSYNC(1); }
    if (p.ph_lo <= 2 && 2 < p.ph_hi) { { if (QKV_FP8) { SchedQKV S{(const char*)p.h8, (const char*)p.Wqkv8, 1, (int)gridDim.x, (int)blockIdx.x}; EpiQKV2 e{p.q, p.k, p.vT, WINV}; pg8::gemm_phase<true, false>(LDSP, D / 2, (size_t)128 * D, S, e); }
        else { SchedQKV S{(const char*)p.h, (const char*)p.Wqkv_t, 2, (int)gridDim.x, (int)blockIdx.x}; EpiQKV2 e{p.q, p.k, p.vT, 1.f}; pg8::gemm_phase<false, false>(LDSP, D, (size_t)128 * D * 2, S, e); } } CVFILL(0, 10000, 96); if (2 + 1 < p.ph_hi) GSYNC(2); }
    if (p.ph_lo <= 3 && 3 < p.ph_hi) { phase_attn(p, smem); if (3 + 1 < p.ph_hi) GSYNC(3); }
    if (p.ph_lo <= 4 && 4 < p.ph_hi) { { SchedPlain S{(const char*)p.o, (const char*)p.Wo0_t, R / 256, 4, D * 2, (int)gridDim.x, (int)blockIdx.x}; EpiYb e{p.y}; pg8::gemm_phase<false, false>(LDSP, D, (size_t)128 * D * 2, S, e); } CVFILL(10000, 21000, 32); if (4 + 1 < p.ph_hi) GSYNC(4); }
    if (p.ph_lo <= 5 && 5 < p.ph_hi) { phase_post_mixer<0>(p, smem); if (5 + 1 < p.ph_hi) GSYNC(5); }
    if (p.ph_lo <= 6 && 6 < p.ph_hi) { phase_topk(p, 0, smem); CVFILL(21000, CV_NITL, 0); if (6 + 1 < p.ph_hi) GSYNC(6); }
    if (p.ph_lo <= 7 && 7 < p.ph_hi) { { SchedMoeUpG S{p.h28, p.Wgu8, p.list, CAP0 / 256, (int)gridDim.x, (int)blockIdx.x}; EpiHb e{p.H8}; pg8::gemm_phase<true, true>(LDSP, D / 2, (size_t)2048 * D, S, e); } if (7 + 1 < p.ph_hi) GSYNC(7); }
    if (p.ph_lo <= 8 && 8 < p.ph_hi) { { SchedMoeDown S{p.H8, p.Wd8, CAP0 / 256, (int)gridDim.x, (int)blockIdx.x}; EpiYMb e{p.XgY, p.gatev, CAP0 / 256}; pg8::gemm_phase<true, false>(LDSP, HID / 2, (size_t)128 * HID, S, e); } CVFILL(CV_NITL, CV_NITL + 15000, 64); if (8 + 1 < p.ph_hi) GSYNC(8); }
    if (p.ph_lo <= 9 && 9 < p.ph_hi) { phase_post_ffn<0>(p); if (9 + 1 < p.ph_hi) GSYNC(9); }
    if (p.ph_lo <= 10 && 10 < p.ph_hi) { { if (MLIN_FP8) { SchedPlain S{(const char*)p.h8, (const char*)p.Win8, R / 256, 13, D, (int)gridDim.x, (int)blockIdx.x}; EpiMLINb e{p.qm, p.km, p.vm, p.om, p.rope, p.gates, p.ml_bgate, WINV}; pg8::gemm_phase<true, false>(LDSP, D / 2, (size_t)128 * D, S, e); }
        else { SchedPlain S{(const char*)p.h, (const char*)p.Win_t, R / 256, 13, D * 2, (int)gridDim.x, (int)blockIdx.x}; EpiMLINb e{p.qm, p.km, p.vm, p.om, p.rope, p.gates, p.ml_bgate, 1.f}; pg8::gemm_phase<false, false>(LDSP, D, (size_t)128 * D * 2, S, e); } } if (10 + 1 < p.ph_hi) GSYNC(10); }
    if (p.ph_lo <= 11 && 11 < p.ph_hi) { phase_mscan(p, smem); if (11 + 1 < p.ph_hi) GSYNC(11); }
    if (p.ph_lo <= 12 && 12 < p.ph_hi) { phase_readout(p); if (12 + 1 < p.ph_hi) GSYNC(12); }
    if (p.ph_lo <= 13 && 13 < p.ph_hi) { { SchedPlain S{(const char*)p.ro, (const char*)p.Wo1_t, NL / 256, 4, D * 2, (int)gridDim.x, (int)blockIdx.x}; EpiYb e{p.y}; pg8::gemm_phase<false, false>(LDSP, D, (size_t)128 * D * 2, S, e); } if (13 + 1 < p.ph_hi) GSYNC(13); }
    if (p.ph_lo <= 14 && 14 < p.ph_hi) { phase_post_mixer<1>(p, smem); if (14 + 1 < p.ph_hi) GSYNC(14); }
    if (p.ph_lo <= 15 && 15 < p.ph_hi) { phase_topk(p, 1, smem); CVFILL(CV_NITL + 15000, CV_NIT, 128); if (15 + 1 < p.ph_hi) GSYNC(15); }
    if (p.ph_lo <= 16 && 16 < p.ph_hi) { { SchedMoeUpG S{p.h28, p.Wgu8 + (size_t)NE * 4096 * D, p.list, CAP1 / 256, (int)gridDim.x, (int)blockIdx.x}; EpiHb e{p.H8}; pg8::gemm_phase<true, true>(LDSP, D / 2, (size_t)2048 * D, S, e); } if (16 + 1 < p.ph_hi) GSYNC(16); }
    if (p.ph_lo <= 17 && 17 < p.ph_hi) { { SchedMoeDown S{p.H8, p.Wd8 + (size_t)NE * 1024 * HID, CAP1 / 256, (int)gridDim.x, (int)blockIdx.x}; EpiYMb e{p.XgY, p.gatev, CAP1 / 256}; pg8::gemm_phase<true, false>(LDSP, HID / 2, (size_t)128 * HID, S, e); } if (17 + 1 < p.ph_hi) GSYNC(17); }
    if (p.ph_lo <= 18 && 18 < p.ph_hi) { phase_post_ffn<1>(p); if (18 + 1 < p.ph_hi) GSYNC(18); }
}

extern "C" void kernel_launch(void* const* d_in, const int* in_sizes, int n_in, void* d_out, int out_size, void* d_ws, size_t ws_size, hipStream_t stream) {
    constexpr size_t MiB = 1u << 20;
    static int grid = 0;
    if (grid == 0) {
        if (n_in != 18 || out_size != NL * D || ws_size < 960 * MiB) { fprintf(stderr, "kernel_launch: unexpected shapes n_in=%d out=%d ws=%zu\n", n_in, out_size, ws_size); grid = -1; return; }
        int dev = 0, cus = 0, per_cu = 0;
        hipGetDevice(&dev); hipDeviceGetAttribute(&cus, hipDeviceAttributeMultiprocessorCount, dev);
        hipFuncSetAttribute((const void*)fwd_kernel, hipFuncAttributeMaxDynamicSharedMemorySize, LDS_BYTES);
        hipOccupancyMaxActiveBlocksPerMultiprocessor(&per_cu, (const void*)fwd_kernel, NTHR, LDS_BYTES);
        if (per_cu < 1) { fprintf(stderr, "kernel_launch: occupancy query says %d blocks/CU\n", per_cu); per_cu = 1; }
        grid = cus;
        (void)hipGetLastError();
    }
    if (grid < 0) return;
    char* ws = (char*)d_ws;
    P p{};
    p.x = (const float*)d_in[0]; p.c = (const float*)d_in[1]; p.ctx = (const float*)d_in[2]; p.c_ctx = (const float*)d_in[3]; p.ada_w = (const float*)d_in[4]; p.ada_b = (const float*)d_in[5];
    p.norm_g = (const float*)d_in[6]; p.na_wqkv = (const float*)d_in[7]; p.na_wout = (const float*)d_in[8]; p.na_relb = (const float*)d_in[9]; p.ml_win = (const float*)d_in[10]; p.ml_bgate = (const float*)d_in[11];
    p.ml_normw = (const float*)d_in[12]; p.ml_wout = (const float*)d_in[13]; p.moe_wr = (const float*)d_in[14]; p.moe_wg = (const float*)d_in[15]; p.moe_wu = (const float*)d_in[16]; p.moe_wd = (const float*)d_in[17];
    p.out = (float*)d_out; p.ctl = (unsigned*)ws; p.xs = (bf16_t*)(ws + 880 * MiB);
    (void)hipMemsetAsync(ws, 0, 65536, stream);
    p.mod = (float*)(ws + 1 * MiB); p.rope = (float*)(ws + 2 * MiB); p.aff = (float*)(ws + 3 * MiB); p.inv = (int*)(ws + 6 * MiB); p.list = (int*)(ws + 9 * MiB); p.gatev = (float*)(ws + 10 * MiB);
    p.gates = (float*)(ws + 11 * MiB); p.xc = (float*)(ws + 16 * MiB);
    p.Wqkv_t = (bf16_t*)(ws + 24 * MiB); p.Wo0_t = (bf16_t*)(ws + 30 * MiB); p.Win_t = (bf16_t*)(ws + 32 * MiB); p.Wo1_t = (bf16_t*)(ws + 39 * MiB);
    p.Wgu8 = (fp8_t*)(ws + 48 * MiB); p.Wd8 = (fp8_t*)(ws + 176 * MiB);
    char* r1 = ws + 256 * MiB;
    p.h = (bf16_t*)r1; p.h8 = (fp8_t*)r1; p.Wqkv8 = (fp8_t*)(ws + 24 * MiB); p.Win8 = (fp8_t*)(ws + 32 * MiB); p.q = (bf16_t*)(r1 + 68 * MiB); p.k = (bf16_t*)(r1 + 136 * MiB); p.vT = (bf16_t*)(r1 + 204 * MiB); p.o = (bf16_t*)(r1 + 272 * MiB);
    p.H = (bf16_t*)r1; p.H8 = (fp8_t*)r1; p.dryx = (float*)(r1 + 136 * MiB);
    p.qm = (bf16_t*)(r1 + 68 * MiB); p.km = (bf16_t*)(r1 + 102 * MiB); p.vm = (bf16_t*)(r1 + 136 * MiB); p.om = (bf16_t*)(r1 + 204 * MiB); p.hf = (bf16_t*)(r1 + 272 * MiB); p.ro = (bf16_t*)(r1 + 68 * MiB);
    p.y = (bf16_t*)(ws + 596 * MiB); p.hb = p.y; p.h2 = (bf16_t*)(ws + 664 * MiB); p.h28 = (fp8_t*)(ws + 664 * MiB); p.XgY = (bf16_t*)(ws + 732 * MiB); p.Xg8 = (fp8_t*)(ws + 732 * MiB);
#if ONE_LAUNCH
    {
#if REP_PHASE >= 0
        const int nl = 3; const int los[3] = {0, REP_PHASE, REP_PHASE}, his[3] = {REP_PHASE, REP_PHASE + 1, NPHASE}; const int drys[3] = {0, 1, 0};
#else
        const int nl = 1; const int los[1] = {0}, his[1] = {NPHASE}; const int drys[1] = {0};
#endif
        for (int li = 0; li < nl; ++li) {
            if (los[li] >= his[li]) continue;
            p.ph_lo = los[li]; p.ph_hi = his[li]; p.dry = drys[li]; p.ctl = (unsigned*)ws + li * 4096;
            void* args[] = {&p};
            hipError_t e = hipLaunchCooperativeKernel((const void*)fwd_kernel, dim3(grid), dim3(NTHR), args, LDS_BYTES, stream);
            if (e != hipSuccess) fprintf(stderr, "cooperative launch failed: %s (grid %d)\n", hipGetErrorString(e), grid);
        }
    }
#else
    for (int ph = 0; ph < NPHASE; ++ph) { p.ph_lo = ph; p.ph_hi = ph + 1; hipLaunchKernelGGL(fwd_kernel, dim3(grid), dim3(NTHR), LDS_BYTES, stream, p); }
#endif
}
```

```cpp
#include <hip/hip_runtime.h>
#include <hip/hip_cooperative_groups.h>
#include <cstdio>
#include <cstdint>
namespace cg = cooperative_groups;

#ifndef REP_PHASE
#define REP_PHASE -1
#endif
#ifndef EXTRA_SYNCS
#define EXTRA_SYNCS 0
#endif
#ifndef QKV_FP8
#define QKV_FP8 1
#endif
#ifndef OUTP_FP8
#define OUTP_FP8 1
#endif
#ifndef MLIN_FP8
#define MLIN_FP8 1
#endif
#ifndef ONE_LAUNCH
#define ONE_LAUNCH 1
#endif

typedef unsigned short bf16_t;
typedef unsigned char fp8_t;
typedef short bf16x8 __attribute__((ext_vector_type(8)));
typedef float f32x4 __attribute__((ext_vector_type(4)));
typedef float f32x2 __attribute__((ext_vector_type(2)));
typedef unsigned u32x4 __attribute__((ext_vector_type(4)));
typedef unsigned u32x2 __attribute__((ext_vector_type(2)));
typedef __bf16 bf16x2_t __attribute__((ext_vector_type(2)));

constexpr int D = 1024, NB = 8, T = 4096, CT = 256, NL = NB * T, NC = NB * CT, R = NL + NC;
constexpr int NE = 16, HID = 2048, CAPL = 512, CAPC = 32, CAP0 = NB * CAPL + NB * CAPC  , CAP1 = NB * CAPL  ;
constexpr int MLW = 3104;
constexpr float EPS = 1e-6f;
constexpr int NTHR = 512, NWAVE = 8;
constexpr int LDS_BYTES = 163840;

struct P {
    const float *x, *c, *ctx, *c_ctx, *ada_w, *ada_b, *norm_g, *na_wqkv, *na_wout, *na_relb, *ml_win, *ml_bgate, *ml_normw, *ml_wout, *moe_wr, *moe_wg, *moe_wu, *moe_wd;
    float* out; unsigned* ctl;
    float *mod, *rope, *aff, *gatev, *gates, *xc;
    int *inv, *list;
    bf16_t *h, *q, *k, *vT, *o, *y, *h2, *XgY, *H, *qm, *km, *vm, *om, *hf, *hb, *ro, *xs;
    bf16_t *Wqkv_t, *Wo0_t, *Win_t, *Wo1_t;
    fp8_t *Wgu8, *Wd8, *h28, *Xg8, *H8, *h8, *Wqkv8, *Win8;
    float* dryx; int ph_lo, ph_hi, dry, pad_;
};

__device__ __forceinline__ int tid_() { int t = (int)threadIdx.x; asm volatile("" : "+v"(t)); return t; }
__device__ __forceinline__ unsigned pk2(float lo, float hi) { f32x2 v = {lo, hi}; bf16x2_t b = __builtin_convertvector(v, bf16x2_t); return __builtin_bit_cast(unsigned, b); }
__device__ __forceinline__ float bflo(unsigned u) { return __uint_as_float(u << 16); }
__device__ __forceinline__ float bfhi(unsigned u) { return __uint_as_float(u & 0xffff0000u); }
__device__ __forceinline__ bf16_t f2bf(float f) { return (bf16_t)(pk2(f, 0.f) & 0xffffu); }
__device__ __forceinline__ float bf2f(bf16_t h) { return __uint_as_float(((unsigned)h) << 16); }
template <int CTRL> __device__ __forceinline__ float dpp_(float v) { return __uint_as_float((unsigned)__builtin_amdgcn_update_dpp(0, (int)__float_as_uint(v), CTRL, 0xf, 0xf, true)); }
__device__ __forceinline__ float x16_sum(float v) { auto r = __builtin_amdgcn_permlane16_swap(__float_as_uint(v), __float_as_uint(v), false, false); return __uint_as_float(r[0]) + __uint_as_float(r[1]); }
__device__ __forceinline__ float x32_sum(float v) { auto r = __builtin_amdgcn_permlane32_swap(__float_as_uint(v), __float_as_uint(v), false, false); return __uint_as_float(r[0]) + __uint_as_float(r[1]); }
__device__ __forceinline__ float x16_max(float v) { auto r = __builtin_amdgcn_permlane16_swap(__float_as_uint(v), __float_as_uint(v), false, false); return fmaxf(__uint_as_float(r[0]), __uint_as_float(r[1])); }
__device__ __forceinline__ float x32_max(float v) { auto r = __builtin_amdgcn_permlane32_swap(__float_as_uint(v), __float_as_uint(v), false, false); return fmaxf(__uint_as_float(r[0]), __uint_as_float(r[1])); }
__device__ __forceinline__ float row_sum16(float v) { v += dpp_<0xB1>(v); v += dpp_<0x4E>(v); v += dpp_<0x141>(v); v += dpp_<0x140>(v); return v; }
__device__ __forceinline__ float wave_sum(float v) { v = row_sum16(v); v = x16_sum(v); return x32_sum(v); }
template <int CTRL, int RMASK> __device__ __forceinline__ float dppo_(float old, float v) { return __uint_as_float((unsigned)__builtin_amdgcn_update_dpp((int)__float_as_uint(old), (int)__float_as_uint(v), CTRL, RMASK, 0xf, false)); }
__device__ __forceinline__ float wave_scan_add(float x) {
    x += dppo_<0x111, 0xf>(0.f, x); x += dppo_<0x112, 0xf>(0.f, x); x += dppo_<0x114, 0xf>(0.f, x); x += dppo_<0x118, 0xf>(0.f, x);
    x += dppo_<0x142, 0xa>(0.f, x); x += dppo_<0x143, 0xc>(0.f, x); return x;
}
__device__ __forceinline__ float wave_scan_max(float x) {
    x = fmaxf(x, dppo_<0x111, 0xf>(-3e38f, x)); x = fmaxf(x, dppo_<0x112, 0xf>(-3e38f, x)); x = fmaxf(x, dppo_<0x114, 0xf>(-3e38f, x)); x = fmaxf(x, dppo_<0x118, 0xf>(-3e38f, x));
    x = fmaxf(x, dppo_<0x142, 0xa>(-3e38f, x)); x = fmaxf(x, dppo_<0x143, 0xc>(-3e38f, x)); return x;
}
__device__ __forceinline__ float sigmoidf_(float v) { return __builtin_amdgcn_rcpf(1.f + __builtin_amdgcn_exp2f(-1.4426950408889634f * v)); }
__device__ __forceinline__ float siluf_(float v) { return v * __builtin_amdgcn_rcpf(1.f + __builtin_amdgcn_exp2f(-1.4426950408889634f * v)); }
__device__ __forceinline__ bf16x8 pack8(const float* t) {
    u32x4 w; w.x = pk2(t[0], t[1]); w.y = pk2(t[2], t[3]); w.z = pk2(t[4], t[5]); w.w = pk2(t[6], t[7]); return __builtin_bit_cast(bf16x8, w);
}
typedef int v8i_t __attribute__((ext_vector_type(8)));
typedef int v4i_t __attribute__((ext_vector_type(4)));
constexpr float WSCALE = 32.f, WINV = 1.f / 32.f, OSCALE = 8.f;
static_assert(WSCALE == 32.f, "EpiHb folds WINV^2 = 2^-10 into its exponent");
__device__ __forceinline__ unsigned pk4f8(float a, float b, float c, float d) { int w = __builtin_amdgcn_cvt_pk_fp8_f32(a, b, 0, false); w = __builtin_amdgcn_cvt_pk_fp8_f32(c, d, w, true); return (unsigned)w; }
#define MFMA16(a, b, c) __builtin_amdgcn_mfma_f32_16x16x32_bf16((a), (b), (c), 0, 0, 0)

__device__ __forceinline__ void phase_mod(const P& p, char* smem) {
    float* sc = (float*)smem;
    float* red = sc + 9 * 1024;
    for (int i = tid_(); i < 9 * 1024; i += NTHR) { const int s = i >> 10, k = i & 1023; const float v = s < 8 ? p.c[s * 1024 + k] : p.c_ctx[k]; sc[i] = v / (1.f + expf(-v)); }
    __syncthreads();
    const int kg = tid_() >> 6, col = tid_() & 63;
    for (int item = blockIdx.x; item < 192; item += gridDim.x) {
        const int l = item / 96, n0 = (item % 96) * 64;
        float acc[9];
#pragma unroll
        for (int s = 0; s < 9; ++s) acc[s] = 0.f;
        const float* w = p.ada_w + ((size_t)l * 1024 + kg * 128) * 6144 + n0 + col;
        for (int k = 0; k < 128; ++k) {
            const float wv = __builtin_nontemporal_load(w + (size_t)k * 6144);
#pragma unroll
            for (int s = 0; s < 9; ++s) acc[s] += sc[s * 1024 + kg * 128 + k] * wv;
        }
#pragma unroll
        for (int s = 0; s < 9; ++s) red[(kg * 9 + s) * 64 + col] = acc[s];
        __syncthreads();
        for (int i = tid_(); i < 576; i += NTHR) {
            const int s = i >> 6, cc = i & 63; float t = 0.f;
#pragma unroll
            for (int k2 = 0; k2 < 8; ++k2) t += red[(k2 * 9 + s) * 64 + cc];
            p.mod[(l * 9 + s) * 6144 + n0 + cc] = t + p.ada_b[l * 6144 + n0 + cc];
        }
        __syncthreads();
    }
    if (blockIdx.x == gridDim.x - 1) {
        for (int i = tid_(); i < 64 * 16; i += NTHR) {
            const int pos = i >> 4, j = i & 15;
            const float inv = exp2f(-(float)j * (13.287712379549449f / 16.0f));
            const float ang = (float)pos * inv;
            float rev = ang * 0.15915494309189535f; rev = rev - floorf(rev);
            p.rope[2 * i] = __builtin_amdgcn_cosf(rev); p.rope[2 * i + 1] = __builtin_amdgcn_sinf(rev);
        }
    }
}

__device__ __forceinline__ void phase_norm0(const P& p) {
    const int lane = tid_() & 63, gw = blockIdx.x * NWAVE + (tid_() >> 6), ngw = gridDim.x * NWAVE;
    const f32x4* g4 = (const f32x4*)(p.norm_g);
    for (int row = gw; row < R; row += ngw) {
        const float* src = row < NL ? p.x + (size_t)row * D : p.ctx + (size_t)(row - NL) * D;
        const int s = row < NL ? (row >> 12) : 8;
        const float* md = p.mod + (size_t)(0 * 9 + s) * 6144;
        f32x4 v[4]; float ss = 0.f;
#pragma unroll
        for (int j = 0; j < 4; ++j) { v[j] = __builtin_nontemporal_load((const f32x4*)src + lane + 64 * j); ss += v[j].x * v[j].x + v[j].y * v[j].y + v[j].z * v[j].z + v[j].w * v[j].w; }
        ss = wave_sum(ss); const float rs = __builtin_amdgcn_rsqf(ss * (1.f / D) + EPS);
        u32x2* dst = (u32x2*)(p.h + (size_t)row * D);
#pragma unroll
        for (int j = 0; j < 4; ++j) {
            const int ci = lane + 64 * j; const f32x4 gg = g4[ci], sh = ((const f32x4*)md)[ci], scv = ((const f32x4*)(md + 1024))[ci];
            f32x4 o = v[j] * rs * gg * (scv + 1.f) + sh;
            if (QKV_FP8) ((unsigned*)(p.h8 + (size_t)row * D))[ci] = pk4f8(o.x, o.y, o.z, o.w);
            else { u32x2 w; w.x = pk2(o.x, o.y); w.y = pk2(o.z, o.w); dst[ci] = w; }
        }
    }
}

template <bool DUAL, class Epi>
__device__ __forceinline__ void gemm_naive(const bf16_t* A, int lda, size_t strideA, const float* B, const float* B2, int ldb, size_t strideB, int nbatch, int M, int N, int K, const Epi& epi) {
    const int lane = tid_() & 63, g = lane >> 4, c = lane & 15;
    const int gw = blockIdx.x * NWAVE + (tid_() >> 6), ngw = gridDim.x * NWAVE;
    const int tm = M / 64, tn = N / 32; const long per = (long)tm * tn, ntile = per * nbatch;
    for (long t = gw; t < ntile; t += ngw) {
        const int bt = (int)(t / per); const int rem = (int)(t % per); const int mt = rem / tn, nt = rem % tn;
        f32x4 acc[4][2], acc2[4][2];
#pragma unroll
        for (int m = 0; m < 4; ++m)
#pragma unroll
            for (int n = 0; n < 2; ++n) { acc[m][n] = (f32x4){0.f, 0.f, 0.f, 0.f}; acc2[m][n] = (f32x4){0.f, 0.f, 0.f, 0.f}; }
        const bf16_t* Ab = A + (size_t)bt * strideA + (size_t)(mt * 64 + c) * lda + 8 * g;
        const float* Bb = B + (size_t)bt * strideB + (size_t)(8 * g) * ldb + nt * 32 + c;
        const float* Bb2 = DUAL ? B2 + (size_t)bt * strideB + (size_t)(8 * g) * ldb + nt * 32 + c : nullptr;
        for (int k0 = 0; k0 < K; k0 += 32) {
            bf16x8 af[4], bfr[2], bfr2[2];
#pragma unroll
            for (int m = 0; m < 4; ++m) af[m] = *(const bf16x8*)(Ab + (size_t)(m * 16) * lda + k0);
#pragma unroll
            for (int n = 0; n < 2; ++n) {
                float t8[8];
#pragma unroll
                for (int j = 0; j < 8; ++j) t8[j] = Bb[(size_t)(k0 + j) * ldb + n * 16];
                bfr[n] = pack8(t8);
                if (DUAL) {
#pragma unroll
                    for (int j = 0; j < 8; ++j) t8[j] = Bb2[(size_t)(k0 + j) * ldb + n * 16];
                    bfr2[n] = pack8(t8);
                }
            }
#pragma unroll
            for (int m = 0; m < 4; ++m)
#pragma unroll
                for (int n = 0; n < 2; ++n) { acc[m][n] = MFMA16(bfr[n], af[m], acc[m][n]); if (DUAL) acc2[m][n] = MFMA16(bfr2[n], af[m], acc2[m][n]); }
        }
#pragma unroll
        for (int m = 0; m < 4; ++m) epi(bt, mt * 64 + m * 16 + c, nt * 32 + 4 * g, acc[m][0], acc[m][1], acc2[m][0], acc2[m][1]);
    }
}

__device__ __forceinline__ void st4bf(bf16_t* dst, f32x4 v) { u32x2 w; w.x = pk2(v.x, v.y); w.y = pk2(v.z, v.w); *(u32x2*)dst = w; }

struct EpiQKV {
    bf16_t *q, *k, *vT;
    __device__ __forceinline__ void one(int row, int col, f32x4 v) const {
        if (col < 1024) st4bf(q + (size_t)row * D + col, v * 0.125f);
        else if (col < 2048) st4bf(k + (size_t)row * D + (col - 1024), v);
        else { const int d = col - 2048;
#pragma unroll
            for (int i = 0; i < 4; ++i) vT[(size_t)(d + i) * R + row] = f2bf(v[i]); }
    }
    __device__ __forceinline__ void operator()(int, int row, int col, f32x4 v0, f32x4 v1, f32x4, f32x4) const { one(row, col, v0); one(row, col + 16, v1); }
};
struct EpiY {
    bf16_t* y;
    __device__ __forceinline__ void operator()(int, int row, int col, f32x4 v0, f32x4 v1, f32x4, f32x4) const { st4bf(y + (size_t)row * D + col, v0); st4bf(y + (size_t)row * D + col + 16, v1); }
};
struct EpiH {
    bf16_t* H; int cap;
    __device__ __forceinline__ void operator()(int bt, int row, int col, f32x4 a0, f32x4 a1, f32x4 u0, f32x4 u1) const {
        bf16_t* d = H + ((size_t)bt * cap + row) * HID + col;
        f32x4 r0, r1;
#pragma unroll
        for (int i = 0; i < 4; ++i) { r0[i] = siluf_(a0[i]) * u0[i]; r1[i] = siluf_(a1[i]) * u1[i]; }
        st4bf(d, r0); st4bf(d + 16, r1);
    }
};
struct EpiYM {
    bf16_t* Y; const float* gatev; int cap;
    __device__ __forceinline__ void operator()(int bt, int row, int col, f32x4 v0, f32x4 v1, f32x4, f32x4) const {
        const float gv = gatev[bt * CAP0 + row]; bf16_t* d = Y + ((size_t)bt * cap + row) * D + col;
        st4bf(d, v0 * gv); st4bf(d + 16, v1 * gv);
    }
};
struct EpiMLIN {
    bf16_t *qm, *km, *vm, *om; float* gates; const float* rope; const float* bgate;
    __device__ __forceinline__ void operator()(int, int row, int col, f32x4 v0, f32x4 v1, f32x4, f32x4) const {
        if (col < 1024) {
            const bool isk = col >= 512; const int cc = isk ? col - 512 : col;
            if (row < NL) {
                const int t = row & 4095; const int hd = cc & 63; const int pos = (hd < 32) ? (t >> 6) : (t & 63); const int j0 = hd & 15;
                const float* rp = rope + (pos * 16 + j0) * 2;
#pragma unroll
                for (int i = 0; i < 4; ++i) { const float cs = rp[2 * i], sn = rp[2 * i + 1]; const float a = v0[i], b = v1[i]; v0[i] = a * cs - b * sn; v1[i] = a * sn + b * cs; }
            }
            if (isk) { v0 = v0 * 0.125f; v1 = v1 * 0.125f; }
            bf16_t* d = (isk ? km : qm) + (size_t)row * 512 + cc; st4bf(d, v0); st4bf(d + 16, v1);
        } else if (col < 2048) { bf16_t* d = vm + (size_t)row * D + (col - 1024); st4bf(d, v0); st4bf(d + 16, v1); }
        else if (col < 3072) { bf16_t* d = om + (size_t)row * D + (col - 2048); st4bf(d, v0); st4bf(d + 16, v1); }
        else { const int gc = col - 3072;
            f32x4 o0, o1;
#pragma unroll
            for (int i = 0; i < 4; ++i) { o0[i] = v0[i] + bgate[gc + i]; const float f = v1[i] + bgate[gc + 16 + i]; o1[i] = fminf(f, 0.f) - log1pf(__expf(-fabsf(f))); }
            *(f32x4*)(gates + (size_t)row * 32 + gc) = o0; *(f32x4*)(gates + (size_t)row * 32 + gc + 16) = o1; }
    }
};


namespace pg8 {
#define PG8_LAS __attribute__((address_space(3)))
constexpr int BM = 256, BK = 64, HALF = 128, HTB = HALF * BK * 2, STAGE_BYTES = 8 * HTB, NXCD = 8, WGM = 4;
__host__ __device__ __forceinline__ int lds_byte(int r, int c) { const int st = (r >> 4) * 2 + (c >> 5), rr = r & 15, cc = c & 31, ob = rr * 64 + cc * 2; return st * 1024 + (ob ^ (((ob >> 9) & 1) << 5)); }
__host__ __device__ __forceinline__ void stage_rc(int b, int& R_, int& C_) { const int st = b / 1024, sb = b % 1024, swz = sb ^ (((sb >> 9) & 1) << 5); R_ = (st >> 1) * 16 + swz / 64; C_ = (st & 1) * 32 + (swz % 64) / 2; }
__host__ __device__ __forceinline__ int perm32(int rho) { const int n = rho >> 4, i = rho & 15; return 8 * (i >> 2) + 4 * n + (i & 3); }
struct Unit { const char* a; const char* b; const int* lst; int pm, pn, job; };
__device__ __forceinline__ void tile_of(int L, int nM, int nN, int& pm, int& pn) {
    const int nwg = nM * nN; int wgid = L; { const int q = nwg / NXCD, r = nwg % NXCD, xcd = wgid % NXCD, off = wgid / NXCD; wgid = (xcd < r ? xcd * (q + 1) : r * (q + 1) + (xcd - r) * q) + off; }
    const int nig = WGM * nN, gid = wgid / nig, fm = gid * WGM, gsz = (nM - fm) < WGM ? (nM - fm) : WGM;
    pm = fm + ((wgid % nig) % gsz); pn = (wgid % nig) / gsz;
}
template <bool FP8, bool GATH, class Epi, class Sched>
__device__ __forceinline__ void gemm_phase(PG8_LAS unsigned char* lds, const int K, const size_t bhs  , const Sched& S, const Epi& E) {
    const int tid = tid_(), wid = __builtin_amdgcn_readfirstlane(tid >> 6), lane = tid & 63, wr = wid >> 2, wc = wid & 3, fr = lane & 15, fq = lane >> 4;
    const int nt = K / BK;
    unsigned voffA[2], voffB[2]; int arow[2]; unsigned acol[2];
#pragma unroll
    for (int i = 0; i < 2; ++i) { int R_, C_; stage_rc(tid * 16 + i * 8192, R_, C_); const int Rb = Epi::PERM ? ((R_ & ~31) + perm32(R_ & 31)) : R_;
        voffA[i] = (unsigned)(R_ * K + C_) * 2u; voffB[i] = (unsigned)(Rb * K + C_) * 2u; arow[i] = R_; acol[i] = (unsigned)C_ * 2u; }
    unsigned vA[2][2], vAn[2][2];
#define PG8_LOADOFF(dst, u) do { _Pragma("unroll") for (int h_ = 0; h_ < 2; ++h_) _Pragma("unroll") for (int i_ = 0; i_ < 2; ++i_) dst[h_][i_] = (unsigned)(u).lst[h_ * HALF + arow[i_]] * (unsigned)(K * 2) + acol[i_]; } while (0)
#define PG8_STAGE_A(bufoff, aptr, h, nx) do { if constexpr (GATH) { unsigned vv_[2]; vv_[0] = (nx) ? vAn[h][0] : vA[h][0]; vv_[1] = (nx) ? vAn[h][1] : vA[h][1]; PG8_STAGE(bufoff, aptr, vv_); } \
        else { PG8_STAGE(bufoff, (aptr) + (h) * ahs, voffA); } } while (0)
    const size_t kstep = (size_t)(BK * 2);
    const size_t ahs = (size_t)HALF * K * 2;
    const unsigned ldsw = (unsigned)wid * 1024u;
    const int aoff = lds_byte(wr * 64 + fr, fq * 8), boff = lds_byte(wc * 32 + fr, fq * 8);
#define PG8_SA(b, h) (((b) * 2 + (h)) * HTB)
#define PG8_SB(b, h) ((4 + (b) * 2 + (h)) * HTB)
#define PG8_STAGE(bufoff, gbase, voff) do { _Pragma("unroll") for (int _i = 0; _i < 2; ++_i) \
        __builtin_amdgcn_global_load_lds((const unsigned*)((const char*)(gbase) + (voff)[_i]), (PG8_LAS unsigned*)(lds + (bufoff) + ldsw + _i * 8192), 16, 0, 0); } while (0)
#define PG8_LDA(dst, b, h) do { _Pragma("unroll") for (int m = 0; m < 4; ++m) _Pragma("unroll") for (int k = 0; k < 2; ++k) dst[m][k] = *(const PG8_LAS bf16x8*)(lds + PG8_SA(b, h) + aoff + m * 2048 + k * 1024); } while (0)
#define PG8_LDB(dst, b, h) do { _Pragma("unroll") for (int n = 0; n < 2; ++n) _Pragma("unroll") for (int k = 0; k < 2; ++k) dst[n][k] = *(const PG8_LAS bf16x8*)(lds + PG8_SB(b, h) + boff + n * 2048 + k * 1024); } while (0)
#define PG8_CAT(x, y) __builtin_shufflevector(__builtin_bit_cast(v4i_t, x), __builtin_bit_cast(v4i_t, y), 0, 1, 2, 3, 4, 5, 6, 7)
#define PG8_MMA(ai, bj, At, Bt) do { __builtin_amdgcn_s_setprio(1); if constexpr (FP8) { _Pragma("unroll") for (int m = 0; m < 4; ++m) _Pragma("unroll") for (int n = 0; n < 2; ++n) \
        { const v8i_t a8_ = PG8_CAT(Bt[n][0], Bt[n][1]), b8_ = PG8_CAT(At[m][0], At[m][1]); asm volatile("v_mfma_scale_f32_16x16x128_f8f6f4 %0, %1, %2, %0, %3, %3 op_sel_hi:[0,0,0]" : "+v"(acc[ai][bj][m][n]) : "v"(a8_), "v"(b8_), "v"(sc127)); } } \
        else { _Pragma("unroll") for (int m = 0; m < 4; ++m) _Pragma("unroll") for (int n = 0; n < 2; ++n) _Pragma("unroll") for (int k = 0; k < 2; ++k) \
        acc[ai][bj][m][n] = __builtin_amdgcn_mfma_f32_16x16x32_bf16(Bt[n][k], At[m][k], acc[ai][bj][m][n], 0, 0, 0); } __builtin_amdgcn_s_setprio(0); } while (0)
#define PG8_MMAZ(ai, bj, At, Bt) do { __builtin_amdgcn_s_setprio(1); if constexpr (FP8) { _Pragma("unroll") for (int m = 0; m < 4; ++m) _Pragma("unroll") for (int n = 0; n < 2; ++n) \
        { const v8i_t a8_ = PG8_CAT(Bt[n][0], Bt[n][1]), b8_ = PG8_CAT(At[m][0], At[m][1]); asm volatile("v_mfma_scale_f32_16x16x128_f8f6f4 %0, %1, %2, 0, %3, %3 op_sel_hi:[0,0,0]" : "=&v"(acc[ai][bj][m][n]) : "v"(a8_), "v"(b8_), "v"(sc127)); } } \
        else { _Pragma("unroll") for (int m = 0; m < 4; ++m) _Pragma("unroll") for (int n = 0; n < 2; ++n) { \
        acc[ai][bj][m][n] = __builtin_amdgcn_mfma_f32_16x16x32_bf16(Bt[n][0], At[m][0], (f32x4){0.f, 0.f, 0.f, 0.f}, 0, 0, 0); acc[ai][bj][m][n] = __builtin_amdgcn_mfma_f32_16x16x32_bf16(Bt[n][1], At[m][1], acc[ai][bj][m][n], 0, 0, 0); } } __builtin_amdgcn_s_setprio(0); } while (0)
#define PG8_WAIT_V(n) asm volatile("s_waitcnt vmcnt(" #n ")" ::: "memory")
#define PG8_WAIT_L(n) asm volatile("s_waitcnt lgkmcnt(" #n ")" ::: "memory")
#define PG8_BAR __builtin_amdgcn_s_barrier()
#define PG8_SCHED __builtin_amdgcn_sched_barrier(0)
    Unit cur, nxt; int ui = 0;
    if (!S.next(0, cur)) return;
    int sc127 = 0x7f7f7f7f; asm volatile("" : "+v"(sc127));
    f32x4 acc[2][2][4][2];
#pragma unroll
    for (int a = 0; a < 2; ++a)
#pragma unroll
        for (int b = 0; b < 2; ++b)
#pragma unroll
            for (int m = 0; m < 4; ++m)
#pragma unroll
                for (int n = 0; n < 2; ++n) acc[a][b][m][n] = (f32x4){0.f, 0.f, 0.f, 0.f};
    bf16x8 At[4][2], B0[2][2], B1[2][2];
    const char* cA = cur.a; const char* cB = cur.b;
    if constexpr (GATH) { PG8_LOADOFF(vA, cur); PG8_LOADOFF(vAn, cur); }
    PG8_STAGE(PG8_SB(0, 0), cB, voffB); PG8_STAGE(PG8_SB(0, 1), cB + bhs, voffB); PG8_STAGE_A(PG8_SA(0, 0), cA, 0, false); PG8_STAGE_A(PG8_SA(0, 1), cA, 1, false);
    if (wr == 1) PG8_BAR;
    PG8_WAIT_V(2); PG8_BAR;
    PG8_STAGE(PG8_SB(1, 0), cB + kstep, voffB); PG8_STAGE_A(PG8_SA(1, 0), cA + kstep, 0, false); PG8_STAGE(PG8_SB(1, 1), cB + bhs + kstep, voffB);
    PG8_WAIT_V(6); PG8_BAR;
    for (;;) {
        const bool has_next = S.next(ui + 1, nxt);
        const char* nA = has_next ? nxt.a : cA; const char* nB = has_next ? nxt.b : cB;
        if constexpr (GATH) { if (has_next) { PG8_LOADOFF(vAn, nxt); } }
        for (int t = 0; t < nt; t += 2) {
            const bool last = (t == nt - 2);
            const char* a1 = cA + (size_t)(t + 1) * kstep;
            const char* a2 = last ? nA : cA + (size_t)(t + 2) * kstep; const char* b2 = last ? nB : cB + (size_t)(t + 2) * kstep;
            const char* a3 = a2 + kstep; const char* b3 = b2 + kstep; const bool nx = last && has_next;
            PG8_LDB(B0, 0, 0); PG8_LDB(B1, 0, 1); PG8_SCHED; PG8_LDA(At, 0, 0); PG8_STAGE_A(PG8_SA(1, 1), a1, 1, false);
            PG8_WAIT_V(8); PG8_WAIT_L(0); PG8_BAR; if (t == 0) { PG8_MMAZ(0, 0, At, B0); PG8_MMAZ(0, 1, At, B1); } else { PG8_MMA(0, 0, At, B0); PG8_MMA(0, 1, At, B1); } PG8_BAR; PG8_SCHED;
            PG8_LDA(At, 0, 1); PG8_STAGE(PG8_SB(0, 0), b2, voffB); PG8_STAGE(PG8_SB(0, 1), b2 + bhs, voffB); PG8_STAGE_A(PG8_SA(0, 0), a2, 0, nx);
            PG8_WAIT_V(8); PG8_WAIT_L(0); PG8_BAR; if (t == 0) { PG8_MMAZ(1, 0, At, B0); PG8_MMAZ(1, 1, At, B1); } else { PG8_MMA(1, 0, At, B0); PG8_MMA(1, 1, At, B1); } PG8_BAR; PG8_SCHED;
            PG8_LDB(B0, 1, 0); PG8_LDB(B1, 1, 1); PG8_SCHED; PG8_LDA(At, 1, 0); PG8_STAGE_A(PG8_SA(0, 1), a2, 1, nx);
            PG8_WAIT_V(8); PG8_WAIT_L(0); PG8_BAR; PG8_MMA(0, 0, At, B0); PG8_MMA(0, 1, At, B1); PG8_BAR; PG8_SCHED;
            PG8_LDA(At, 1, 1); PG8_STAGE(PG8_SB(1, 0), b3, voffB); PG8_STAGE(PG8_SB(1, 1), b3 + bhs, voffB); PG8_STAGE_A(PG8_SA(1, 0), a3, 0, nx);
            PG8_WAIT_V(8); PG8_WAIT_L(0); PG8_BAR; PG8_MMA(1, 0, At, B0); PG8_MMA(1, 1, At, B1); PG8_BAR; PG8_SCHED;
        }
        if (wr == 0) PG8_BAR;
        if constexpr (FP8) { asm volatile("s_nop 15\n\ts_nop 15" ::: "memory"); }
        E(acc, cur, wr, wc, fr, fq);
        if (!has_next) break;
        cur = nxt; cA = nA; cB = nB; ++ui;
        if constexpr (GATH) { _Pragma("unroll") for (int h_ = 0; h_ < 2; ++h_) _Pragma("unroll") for (int i_ = 0; i_ < 2; ++i_) vA[h_][i_] = vAn[h_][i_]; }
        if (wr == 1) PG8_BAR;
    }
    PG8_WAIT_V(0);
    PG8_BAR;
#undef PG8_SA
#undef PG8_SB
#undef PG8_STAGE
#undef PG8_STAGE_A
#undef PG8_LOADOFF
#undef PG8_LDA
#undef PG8_LDB
#undef PG8_MMA
#undef PG8_MMAZ
#undef PG8_CAT
#undef PG8_WAIT_V
#undef PG8_WAIT_L
#undef PG8_BAR
#undef PG8_SCHED
}
}

typedef float accT[2][2][4][2][4];
__device__ __forceinline__ void st8bf(bf16_t* dst, f32x4 a, f32x4 b) { u32x4 w; w.x = pk2(a.x, a.y); w.y = pk2(a.z, a.w); w.z = pk2(b.x, b.y); w.w = pk2(b.z, b.w); *(u32x4*)dst = w; }

struct SchedQKV {
    const char *h, *W; int es, G, c;
    __device__ __forceinline__ bool next(int i, pg8::Unit& u) const {
        const int L = i * G + c; if (L >= 1088 + 544) return false;
        if (L < 1088) { pg8::tile_of(L, 136, 8, u.pm, u.pn); u.job = 0; u.a = h + (size_t)u.pm * 256 * D * es; u.b = W + (size_t)u.pn * 256 * D * es; }
        else { pg8::tile_of(L - 1088, 4, 136, u.pm, u.pn); u.job = 1; u.a = W + (size_t)(2048 + u.pm * 256) * D * es; u.b = h + (size_t)u.pn * 256 * D * es; }
        return true;
    }
};
struct SchedPlain {
    const char *A, *Bt; int nM, nN, KB  , G, c;
    __device__ __forceinline__ bool next(int i, pg8::Unit& u) const {
        const int L = i * G + c; if (L >= nM * nN) return false;
        pg8::tile_of(L, nM, nN, u.pm, u.pn); u.job = 0; u.a = A + (size_t)u.pm * 256 * KB; u.b = Bt + (size_t)u.pn * 256 * KB; return true;
    }
};
struct SchedMoeUp {
    const fp8_t *Xg, *Wgu; int tmE, G, c;
    __device__ __forceinline__ bool next(int i, pg8::Unit& u) const {
        const int L = i * G + c; if (L >= NE * tmE * 16) return false;
        pg8::tile_of(L, NE * tmE, 16, u.pm, u.pn); const int e = u.pm / tmE; u.job = e;
        u.a = (const char*)(Xg + (size_t)u.pm * 256 * D); u.b = (const char*)(Wgu + ((size_t)e * 4096 + u.pn * 128) * D); return true;
    }
};
struct SchedMoeUpG {
    const fp8_t *h28, *Wgu; const int* list; int tmE, G, c;
    __device__ __forceinline__ bool next(int i, pg8::Unit& u) const {
        const int L = i * G + c; if (L >= NE * tmE * 16) return false;
        pg8::tile_of(L, NE * tmE, 16, u.pm, u.pn); const int e = u.pm / tmE; u.job = e;
        u.a = (const char*)h28; u.lst = list + e * CAP0 + (u.pm - e * tmE) * 256; u.b = (const char*)(Wgu + ((size_t)e * 4096 + u.pn * 128) * D); return true;
    }
};
struct SchedMoeDown {
    const fp8_t *Hh, *Wd; int tmE, G, c;
    __device__ __forceinline__ bool next(int i, pg8::Unit& u) const {
        const int L = i * G + c; if (L >= NE * tmE * 4) return false;
        pg8::tile_of(L, NE * tmE, 4, u.pm, u.pn); const int e = u.pm / tmE; u.job = e;
        u.a = (const char*)(Hh + (size_t)u.pm * 256 * HID); u.b = (const char*)(Wd + ((size_t)e * 1024 + u.pn * 256) * HID); return true;
    }
};
struct EpiQKV2 { static constexpr bool PERM = true;
    bf16_t *q, *k, *vT; float osc;
    __device__ __forceinline__ void operator()(const f32x4 (&acc)[2][2][4][2], const pg8::Unit& u, int wr, int wc, int fr, int fq) const {
        const int row0 = u.pm * 256 + wr * 64 + fr, col0 = u.pn * 256 + wc * 32 + 8 * fq;
        bf16_t* base; size_t ld; float sc = 1.f;
        if (u.job == 0) { ld = D; if (col0 < 1024) { base = q + col0; sc = 0.125f * 1.4426950408889634f; } else base = k + (col0 - 1024); }
        else { ld = R; base = vT + col0; }
#pragma unroll
        for (int ai = 0; ai < 2; ++ai)
#pragma unroll
            for (int m = 0; m < 4; ++m) { bf16_t* rp = base + (size_t)(row0 + ai * 128 + m * 16) * ld;
#pragma unroll
                for (int bj = 0; bj < 2; ++bj) st8bf(rp + bj * 128, acc[ai][bj][m][0] * (sc * osc), acc[ai][bj][m][1] * (sc * osc)); }
    }
};
struct EpiYb { static constexpr bool PERM = true;
    bf16_t* y; float osc;
    __device__ __forceinline__ void operator()(const f32x4 (&acc)[2][2][4][2], const pg8::Unit& u, int wr, int wc, int fr, int fq) const {
        const int row0 = u.pm * 256 + wr * 64 + fr, col0 = u.pn * 256 + wc * 32 + 8 * fq;
#pragma unroll
        for (int ai = 0; ai < 2; ++ai)
#pragma unroll
            for (int m = 0; m < 4; ++m) { bf16_t* rp = y + (size_t)(row0 + ai * 128 + m * 16) * D + col0;
#pragma unroll
                for (int bj = 0; bj < 2; ++bj) st8bf(rp + bj * 128, acc[ai][bj][m][0] * osc, acc[ai][bj][m][1] * osc); }
    }
};
struct EpiHb { static constexpr bool PERM = true;
    fp8_t* H;
    __device__ __forceinline__ void operator()(const f32x4 (&acc)[2][2][4][2], const pg8::Unit& u, int wr, int wc, int fr, int fq) const {
        const int row0 = u.pm * 256 + wr * 64 + fr, col0 = u.pn * 128 + wc * 32 + 8 * fq;
        constexpr float C1 = -1.4426950408889634f * WINV;
#pragma unroll
        for (int ai = 0; ai < 2; ++ai)
#pragma unroll
            for (int m = 0; m < 4; ++m) { float e[8], t[8];
#pragma unroll
                for (int i = 0; i < 8; ++i) { const float g = acc[ai][0][m][i >> 2][i & 3]; e[i] = __builtin_amdgcn_exp2f(__builtin_fmaf(g, C1, 10.f)); t[i] = g * acc[ai][1][m][i >> 2][i & 3]; }
                __builtin_amdgcn_sched_barrier(0);
#pragma unroll
                for (int i = 0; i < 8; ++i) e[i] = __builtin_amdgcn_rcpf(1024.f + e[i]);
                __builtin_amdgcn_sched_barrier(0);
#pragma unroll
                for (int i = 0; i < 8; ++i) t[i] = t[i] * e[i];
                u32x2 w; w.x = pk4f8(t[0], t[1], t[2], t[3]); w.y = pk4f8(t[4], t[5], t[6], t[7]); *(u32x2*)(H + (size_t)(row0 + ai * 128 + m * 16) * HID + col0) = w; }
    }
};
struct EpiYMb { static constexpr bool PERM = true;
    bf16_t* Y; const float* gatev; int tmE;
    __device__ __forceinline__ void operator()(const f32x4 (&acc)[2][2][4][2], const pg8::Unit& u, int wr, int wc, int fr, int fq) const {
        const int row0 = u.pm * 256 + wr * 64 + fr, col0 = u.pn * 256 + wc * 32 + 8 * fq; const int e = u.job, rl0 = row0 - e * tmE * 256;
        float gv[2][4];
#pragma unroll
        for (int ai = 0; ai < 2; ++ai)
#pragma unroll
            for (int m = 0; m < 4; ++m) gv[ai][m] = gatev[e * CAP0 + rl0 + ai * 128 + m * 16];
#pragma unroll
        for (int ai = 0; ai < 2; ++ai)
#pragma unroll
            for (int m = 0; m < 4; ++m) { const float g = gv[ai][m] * WINV; bf16_t* rp = Y + (size_t)(row0 + ai * 128 + m * 16) * D + col0;
#pragma unroll
                for (int bj = 0; bj < 2; ++bj) st8bf(rp + bj * 128, acc[ai][bj][m][0] * g, acc[ai][bj][m][1] * g); }
    }
};
struct EpiMLINb { static constexpr bool PERM = false;
    bf16_t *qm, *km, *vm, *om; const float* rope; float* gates; const float* bgate; float osc;
    __device__ __forceinline__ void operator()(const f32x4 (&acc)[2][2][4][2], const pg8::Unit& u, int wr, int wc, int fr, int fq) const {
        const int row0 = u.pm * 256 + wr * 64 + fr;
        if (u.pn == 12) {
            if (wc == 0) { const int gc = 4 * fq; const f32x4 bi = *(const f32x4*)(bgate + gc), bf = *(const f32x4*)(bgate + 16 + gc);
#pragma unroll
                for (int ai = 0; ai < 2; ++ai)
#pragma unroll
                    for (int m = 0; m < 4; ++m) { const int row = row0 + ai * 128 + m * 16; const f32x4 o0 = acc[ai][0][m][0] * osc + bi; const f32x4 fv = acc[ai][0][m][1] * osc + bf; f32x4 o1;
#pragma unroll
                        for (int i = 0; i < 4; ++i) o1[i] = fminf(fv[i], 0.f) - __logf(1.f + __expf(-fabsf(fv[i])));
                        *(f32x4*)(gates + (size_t)row * 32 + gc) = o0; *(f32x4*)(gates + (size_t)row * 32 + gc + 16) = o1; } }
        } else if (u.pn < 4) {
            const bool isk = u.pn >= 2; bf16_t* dst = isk ? km : qm; const float sc = (isk ? 0.125f : 1.f) * osc;
            const bool lat = (u.pm * 256) < NL;
            const int cc0 = (u.pn & 1) * 256 + wc * 32 + 4 * fq; const int hd = cc0 & 63;
            f32x4 r01[2][4], r23[2][4];
            if (lat) {
#pragma unroll
                for (int ai = 0; ai < 2; ++ai)
#pragma unroll
                    for (int m = 0; m < 4; ++m) { const int row = row0 + ai * 128 + m * 16; const int t = row & 4095; const int pos = (hd < 32) ? (t >> 6) : (t & 63); const f32x4* rp = (const f32x4*)(rope + (pos * 16 + (hd & 15)) * 2); r01[ai][m] = rp[0]; r23[ai][m] = rp[1]; }
            }
#pragma unroll
            for (int ai = 0; ai < 2; ++ai)
#pragma unroll
                for (int m = 0; m < 4; ++m) { const int row = row0 + ai * 128 + m * 16;
#pragma unroll
                    for (int bj = 0; bj < 2; ++bj) { f32x4 v0 = acc[ai][bj][m][0], v1 = acc[ai][bj][m][1];
                        if (lat) { const float c0 = r01[ai][m].x, s0 = r01[ai][m].y, c1 = r01[ai][m].z, s1 = r01[ai][m].w, c2 = r23[ai][m].x, s2 = r23[ai][m].y, c3 = r23[ai][m].z, s3 = r23[ai][m].w;
                            f32x4 a = v0, b = v1;
                            v0 = (f32x4){a.x * c0 - b.x * s0, a.y * c1 - b.y * s1, a.z * c2 - b.z * s2, a.w * c3 - b.w * s3};
                            v1 = (f32x4){a.x * s0 + b.x * c0, a.y * s1 + b.y * c1, a.z * s2 + b.z * c2, a.w * s3 + b.w * c3}; }
                        bf16_t* d = dst + (size_t)row * 512 + cc0 + bj * 128; st4bf(d, v0 * sc); st4bf(d + 16, v1 * sc); } }
        } else {
            bf16_t* dst = (u.pn < 8 ? vm : om) + ((u.pn & 3) * 256) + wc * 32 + 4 * fq;
#pragma unroll
            for (int bj = 0; bj < 2; ++bj)
#pragma unroll
                for (int ai = 0; ai < 2; ++ai)
#pragma unroll
                    for (int m = 0; m < 4; ++m) { bf16_t* d = dst + (size_t)(row0 + ai * 128 + m * 16) * D + bj * 128; st4bf(d, acc[ai][bj][m][0] * osc); st4bf(d + 16, acc[ai][bj][m][1] * osc); }
        }
    }
};
struct EpiGates {
    float* gates; const float* bgate;
    __device__ __forceinline__ void operator()(int, int row, int gc, f32x4 v0, f32x4 v1, f32x4, f32x4) const {
        f32x4 o0, o1;
#pragma unroll
        for (int i = 0; i < 4; ++i) { o0[i] = v0[i] + bgate[gc + i]; const float f = v1[i] + bgate[gc + 16 + i]; o1[i] = fminf(f, 0.f) - log1pf(__expf(-fabsf(f))); }
        *(f32x4*)(gates + (size_t)row * 32 + gc) = o0; *(f32x4*)(gates + (size_t)row * 32 + gc + 16) = o1;
    }
};

__device__ __forceinline__ void transpose_item(const float* W, int K, int N, bf16_t* WT, int row_off, float* scr, int item, int lane) {
    const int nblk = N / 32, kb = item / nblk, nb = item % nblk, k0 = 64 * kb, n0 = 32 * nb;
#pragma unroll 8
    for (int i = 0; i < 32; ++i) { const int kk = 2 * i + (lane >> 5); scr[kk * 33 + (lane & 31)] = __builtin_nontemporal_load(W + (size_t)(k0 + kk) * N + n0 + (lane & 31)); }
    asm volatile("s_waitcnt lgkmcnt(0)" ::: "memory");
    const int c8 = lane & 7;
#pragma unroll
    for (int j = 0; j < 4; ++j) { const int n = (lane >> 3) + 8 * j; const float* s2 = scr + (8 * c8) * 33 + n;
        u32x4 o; o.x = pk2(s2[0 * 33], s2[1 * 33]); o.y = pk2(s2[2 * 33], s2[3 * 33]); o.z = pk2(s2[4 * 33], s2[5 * 33]); o.w = pk2(s2[6 * 33], s2[7 * 33]);
        *(u32x4*)(WT + (size_t)(row_off + n0 + n) * K + k0 + 8 * c8) = o; }
    asm volatile("s_waitcnt lgkmcnt(0)" ::: "memory");
}
__device__ __forceinline__ void transpose_item8(const float* W, int K, int N, fp8_t* WT, int row_off, float* scr, int item, int lane) {
    const int nblk = N / 32, kb = item / nblk, nb = item % nblk, k0 = 64 * kb, n0 = 32 * nb;
#pragma unroll 8
    for (int i = 0; i < 32; ++i) { const int kk = 2 * i + (lane >> 5); scr[kk * 33 + (lane & 31)] = __builtin_nontemporal_load(W + (size_t)(k0 + kk) * N + n0 + (lane & 31)); }
    asm volatile("s_waitcnt lgkmcnt(0)" ::: "memory");
    const int c8 = lane & 7;
#pragma unroll
    for (int j = 0; j < 4; ++j) { const int n = (lane >> 3) + 8 * j; const float* s2 = scr + (8 * c8) * 33 + n;
        u32x2 o; o.x = pk4f8(s2[0 * 33] * WSCALE, s2[1 * 33] * WSCALE, s2[2 * 33] * WSCALE, s2[3 * 33] * WSCALE); o.y = pk4f8(s2[4 * 33] * WSCALE, s2[5 * 33] * WSCALE, s2[6 * 33] * WSCALE, s2[7 * 33] * WSCALE);
        *(u32x2*)(WT + (size_t)(row_off + n0 + n) * K + k0 + 8 * c8) = o; }
    asm volatile("s_waitcnt lgkmcnt(0)" ::: "memory");
}
constexpr int CV_IPM = 512, CV_IPE = 3 * CV_IPM, CV_NITL = NE * CV_IPE, CV_NIT = 2 * CV_NITL;
constexpr int CV_CNT_WORD = 15360;
__device__ __forceinline__ int cv_pull(unsigned* cnt, int lane) { unsigned v = 0; if (lane == 0) v = __hip_atomic_fetch_add(cnt, 1u, __ATOMIC_RELAXED, __HIP_MEMORY_SCOPE_AGENT); return (int)__builtin_amdgcn_readfirstlane(v); }
__device__ __forceinline__ void convert_moe_fill(const P& p, float* scr, int base, int limit, int first_cu, int last_cu = 256) {
    const int lane = tid_() & 63; if (gridDim.x != 256) { first_cu = 0; last_cu = (int)gridDim.x; }
    if ((int)blockIdx.x < first_cu || (int)blockIdx.x >= last_cu) return;
    const int nw = (last_cu - first_cu) * NWAVE; int idx = base + ((int)blockIdx.x - first_cu) * NWAVE + (tid_() >> 6);
    const int lr = lane >> 4, lc = lane & 15;
#define CV_DECODE(idx_, W_, N_, K_, WT_, k0_, n0_) do { const int l_ = (idx_) / CV_NITL, it_ = (idx_) % CV_NITL; const int e_ = it_ / CV_IPE, r_ = it_ % CV_IPE, mat_ = r_ / CV_IPM, q_ = r_ % CV_IPM; \
        if (mat_ == 0) { W_ = p.moe_wg + ((size_t)l_ * NE + e_) * D * HID; N_ = HID; K_ = D; WT_ = p.Wgu8 + ((size_t)l_ * NE + e_) * 4096 * D; } \
        else if (mat_ == 1) { W_ = p.moe_wu + ((size_t)l_ * NE + e_) * D * HID; N_ = HID; K_ = D; WT_ = p.Wgu8 + (((size_t)l_ * NE + e_) * 4096 + 2048) * D; } \
        else { W_ = p.moe_wd + ((size_t)l_ * NE + e_) * HID * D; N_ = D; K_ = HID; WT_ = p.Wd8 + ((size_t)l_ * NE + e_) * 1024 * HID; } \
        const int nb_ = N_ / 64; k0_ = 64 * (q_ / nb_); n0_ = 64 * (q_ % nb_); } while (0)
    f32x4 v[16];
    const float* W; int N, K, k0, n0; fp8_t* WT;
    if (idx < limit) { CV_DECODE(idx, W, N, K, WT, k0, n0);
#pragma unroll
        for (int i = 0; i < 16; ++i) v[i] = __builtin_nontemporal_load((const f32x4*)(W + (size_t)(k0 + 4 * i + lr) * N + n0 + 4 * lc)); }
    while (idx < limit) {
#pragma unroll
        for (int i = 0; i < 16; ++i) { float* d = scr + (4 * i + lr) * 65 + 4 * lc; d[0] = v[i].x; d[1] = v[i].y; d[2] = v[i].z; d[3] = v[i].w; }
        fp8_t* WTc = WT; const int Kc = K, k0c = k0, n0c = n0;
        idx += nw;
        if (idx < limit) { CV_DECODE(idx, W, N, K, WT, k0, n0);
#pragma unroll
            for (int i = 0; i < 16; ++i) v[i] = __builtin_nontemporal_load((const f32x4*)(W + (size_t)(k0 + 4 * i + lr) * N + n0 + 4 * lc)); }
#pragma unroll
        for (int pp = 0; pp < 4; ++pp) { const int n = 16 * pp + (lane >> 2), c = lane & 3; const float* s2 = scr + (16 * c) * 65 + n;
            u32x4 o; o.x = pk4f8(s2[0 * 65] * WSCALE, s2[1 * 65] * WSCALE, s2[2 * 65] * WSCALE, s2[3 * 65] * WSCALE); o.y = pk4f8(s2[4 * 65] * WSCALE, s2[5 * 65] * WSCALE, s2[6 * 65] * WSCALE, s2[7 * 65] * WSCALE);
            o.z = pk4f8(s2[8 * 65] * WSCALE, s2[9 * 65] * WSCALE, s2[10 * 65] * WSCALE, s2[11 * 65] * WSCALE); o.w = pk4f8(s2[12 * 65] * WSCALE, s2[13 * 65] * WSCALE, s2[14 * 65] * WSCALE, s2[15 * 65] * WSCALE);
            __builtin_nontemporal_store(o, (u32x4*)(WTc + (size_t)(n0c + n) * Kc + k0c + 16 * c)); }
        asm volatile("s_waitcnt lgkmcnt(0)" ::: "memory");
    }
#undef CV_DECODE
}
__device__ __forceinline__ void convert_small_weights(const P& p, char* smem) {
    const int lane = tid_() & 63, wid = tid_() >> 6, gw = blockIdx.x * NWAVE + wid, ngw = gridDim.x * NWAVE;
    float* scr = (float*)smem + wid * (64 * 33);
    constexpr int I1 = 16 * 96, I2 = 16 * 32, I3 = 16 * 97, I4 = 16 * 32;
    for (int it = gw; it < I1 + I2 + I3 + I4; it += ngw) {
        int r = it;
        if (r < I1) { if (QKV_FP8) transpose_item8(p.na_wqkv, D, 3 * D, p.Wqkv8, 0, scr, r, lane); else transpose_item(p.na_wqkv, D, 3 * D, p.Wqkv_t, 0, scr, r, lane); continue; } r -= I1;
        if (r < I2) { if (OUTP_FP8) transpose_item8(p.na_wout, D, D, (fp8_t*)p.Wo0_t, 0, scr, r, lane); else transpose_item(p.na_wout, D, D, p.Wo0_t, 0, scr, r, lane); continue; } r -= I2;
        if (r < I3) { if (MLIN_FP8) transpose_item8(p.ml_win, D, MLW, p.Win8, 0, scr, r, lane); else transpose_item(p.ml_win, D, MLW, p.Win_t, 0, scr, r, lane); continue; } r -= I3;
        if (OUTP_FP8) transpose_item8(p.ml_wout, D, D, (fp8_t*)p.Wo1_t, 0, scr, r, lane); else transpose_item(p.ml_wout, D, D, p.Wo1_t, 0, scr, r, lane);
    }
}

__host__ __device__ constexpr unsigned long long attn_mask(int hf, int jb, int j) {
    unsigned long long m = 0ull;
    for (int l = 0; l < 64; ++l) { const int g = l >> 4, c = l & 15, qc = 16 * jb + c; int wc0 = qc - 8; wc0 = wc0 < 0 ? 0 : (wc0 > 48 ? 48 : wc0); const int kc = hf * 32 + 8 * g + j;
        if (kc >= wc0 && kc < wc0 + 16) m |= (1ull << l); }
    return m;
}
__device__ __forceinline__ float amax2(float a, float b) { float r; asm("v_max_f32_e32 %0, %1, %2" : "=v"(r) : "v"(a), "v"(b)); return r; }
__device__ __forceinline__ float amax3(float a, float b, float c) { float r; asm("v_max3_f32 %0, %1, %2, %3" : "=v"(r) : "v"(a), "v"(b), "v"(c)); return r; }
__device__ __forceinline__ float sel_mask(float neg, float val, unsigned long long m) { float r; asm("v_cndmask_b32_e64 %0, %1, %2, %3" : "=v"(r) : "v"(neg), "v"(val), "s"(m)); return r; }
__device__ __forceinline__ float x16_amax(float v) { auto r = __builtin_amdgcn_permlane16_swap(__float_as_uint(v), __float_as_uint(v), false, false); return amax2(__uint_as_float(r[0]), __uint_as_float(r[1])); }
__device__ __forceinline__ float x32_amax(float v) { auto r = __builtin_amdgcn_permlane32_swap(__float_as_uint(v), __float_as_uint(v), false, false); return amax2(__uint_as_float(r[0]), __uint_as_float(r[1])); }

#define ATT_THR 16.f
#define ATT_SOFTMAX_PV(jb, vf, force) do { \
        float mx = __builtin_fmaxf(__builtin_fmaxf(sv[0], sv[1]), sv[2]); mx = __builtin_fmaxf(__builtin_fmaxf(mx, sv[3]), sv[4]); mx = __builtin_fmaxf(__builtin_fmaxf(mx, sv[5]), sv[6]); mx = __builtin_fmaxf(mx, sv[7]); \
        if ((force) || __any(mx > ATT_THR)) { mx = x16_amax(mx); mx = x32_amax(mx); const float dl = (force) ? mx : fmaxf(mx, 0.f); const float alpha = __builtin_amdgcn_exp2f(-dl);        \
            const float nm = negm[jb][0] - dl; negm[jb] = (f32x4){nm, nm, nm, nm}; \
            _Pragma("unroll") for (int j = 0; j < 8; ++j) sv[j] -= dl; \
            OL[jb] = OL[jb] * alpha; _Pragma("unroll") for (int dt = 0; dt < 4; ++dt) O[jb][dt] = O[jb][dt] * alpha; } \
        _Pragma("unroll") for (int j = 0; j < 8; ++j) sv[j] = __builtin_amdgcn_exp2f(sv[j]); \
        const bf16x8 pf = pack8(sv); \
        _Pragma("unroll") for (int dt = 0; dt < 4; ++dt) O[jb][dt] = MFMA16(vf[dt], pf, O[jb][dt]); \
        OL[jb] = MFMA16(onesf, pf, OL[jb]); } while (0)
#define ATT_QK(i_, kf) do { f32x4 s0, s1;        \
        s0 = MFMA16(kf[0][0], qf[i_][0], negm[i_]); s0 = MFMA16(kf[0][1], qf[i_][1], s0); s1 = MFMA16(kf[1][0], qf[i_][0], negm[i_]); s1 = MFMA16(kf[1][1], qf[i_][1], s1); \
        _Pragma("unroll") for (int ii = 0; ii < 4; ++ii) { sv[ii] = s0[ii]; sv[4 + ii] = s1[ii]; } } while (0)
#define ATT_LOADKV(kr0, kf, vf) do { const int kk = (kr0) + 8 * (c >> 2) + (c & 3); \
        _Pragma("unroll") for (int tt = 0; tt < 2; ++tt) _Pragma("unroll") for (int ks = 0; ks < 2; ++ks) kf[tt][ks] = *(const bf16x8*)(p.k + (size_t)(kk + 4 * tt) * D + h * 64 + ks * 32 + 8 * g); \
        _Pragma("unroll") for (int dt = 0; dt < 4; ++dt) vf[dt] = *(const bf16x8*)(p.vT + (size_t)(h * 64 + 16 * dt + c) * R + (kr0) + 8 * g); } while (0)

__device__ __forceinline__ void phase_attn(const P& p, char* smem) {
    const int tid = tid_(), lane = tid & 63, g = lane >> 4, c = lane & 15, wid = tid >> 6;
    const int gw = blockIdx.x * NWAVE + wid, ngw = gridDim.x * NWAVE;
    const int jb = __builtin_amdgcn_readfirstlane(wid & 3), rh = __builtin_amdgcn_readfirstlane(wid >> 2);
    float* relw = (float*)smem + wid * 576;
    bf16_t* KC = (bf16_t*)(smem + 18432); bf16_t* VC = KC + 256 * 72;
    bf16_t* RING = VC + 64 * 264;
    constexpr int SLOT = 2 * 64 * 72;
    for (int i = lane; i < 576; i += 64) relw[i] = 0.f;
    const int kc0 = jb == 0 ? 0 : (jb == 1 ? 8 : (jb == 2 ? 24 : 32));
    unsigned long long wm[8];
#pragma unroll
    for (int j = 0; j < 8; ++j) { const int qc = 16 * jb + c; const int wc0 = min(max(qc - 8, 0), 48); const int kc = kc0 + 8 * g + j; wm[j] = __ballot(kc >= wc0 && kc < wc0 + 16); }
    const unsigned one2 = (c == 0) ? 0x3f803f80u : 0u; const u32x4 one4 = {one2, one2, one2, one2}; const bf16x8 onesf = __builtin_bit_cast(bf16x8, one4);
    const int boff = kc0 - 16 * jb + 8 * g - c + 15;
    int hcur = -1, bhcur = -1;
    const int ntask = NB * 16 * 8, tper = (ntask + (int)gridDim.x - 1) / (int)gridDim.x;
    for (int wt = blockIdx.x * tper; wt < min(ntask, ((int)blockIdx.x + 1) * tper); ++wt) {
        const int b = wt >> 7, h = (wt >> 3) & 15, R0 = (wt & 7) * 8; const bool newbh = (wt >> 3) != bhcur; bhcur = wt >> 3;
        if (h != hcur) { asm volatile("s_waitcnt lgkmcnt(0)" ::: "memory");
            for (int i = lane; i < 465; i += 64) relw[48 + i] = p.na_relb[h * 465 + i] * 1.4426950408889634f;
            asm volatile("s_waitcnt lgkmcnt(0)" ::: "memory"); hcur = h; }
        const int ctx0 = NL + b * CT;
        const int rlo = min(max(R0 - 4, 0), 56), rhi = min(max(R0 + 3, 0), 56) + 8, nrow = rhi - rlo;
        const int skey = tid >> 3, sch = tid & 7;
        const bf16_t* ksrc = p.k + (size_t)(b * T + skey) * D + h * 64 + sch * 8;
        const bf16_t* vsrc = p.vT + (size_t)(h * 64 + skey) * R + b * T + sch * 8;
        __syncthreads();
        { const int key = tid >> 1, hh = tid & 1; const bf16_t* kcs = p.k + (size_t)(ctx0 + key) * D + h * 64 + hh * 32;
          const int dd = tid >> 3, seg = tid & 7; const bf16_t* vcs = p.vT + (size_t)(h * 64 + dd) * R + ctx0 + seg * 32;
          const u32x4 k0 = *(const u32x4*)(ksrc + (size_t)rlo * 64 * D), v0 = *(const u32x4*)(vsrc + rlo * 64);
          if (newbh) { u32x4 kk[4], vv[4];
#pragma unroll
              for (int i = 0; i < 4; ++i) { kk[i] = *(const u32x4*)(kcs + 8 * i); vv[i] = *(const u32x4*)(vcs + 8 * i); }
#pragma unroll
              for (int i = 0; i < 4; ++i) { *(u32x4*)(KC + key * 72 + hh * 32 + 8 * i) = kk[i]; *(u32x4*)(VC + dd * 264 + seg * 32 + 8 * i) = vv[i]; } }
          *(u32x4*)(RING + skey * 72 + sch * 8) = k0; *(u32x4*)(RING + 64 * 72 + skey * 72 + sch * 8) = v0; }
        __syncthreads();
        bf16x8 qf[4][2];
#pragma unroll
        for (int i = 0; i < 4; ++i)
#pragma unroll
            for (int ks = 0; ks < 2; ++ks) qf[i][ks] = __builtin_nontemporal_load((const bf16x8*)(p.q + (size_t)(b * T + (R0 + 4 * rh + i) * 64 + 16 * jb + c) * D + h * 64 + ks * 32 + 8 * g));
        f32x4 O[4][4], OL[4], negm[4];
#pragma unroll
        for (int i = 0; i < 4; ++i) { negm[i] = (f32x4){0.f, 0.f, 0.f, 0.f}; OL[i] = (f32x4){0.f, 0.f, 0.f, 0.f};
#pragma unroll
            for (int dt = 0; dt < 4; ++dt) O[i][dt] = (f32x4){0.f, 0.f, 0.f, 0.f}; }
        bf16x8 kf[2][2], vf[4];
#pragma unroll 1
        for (int st = 0; st < 8; ++st) {
            { const int kk = st * 32 + 8 * (c >> 2) + (c & 3);
#pragma unroll
              for (int tt = 0; tt < 2; ++tt)
#pragma unroll
                  for (int ks = 0; ks < 2; ++ks) kf[tt][ks] = *(const bf16x8*)(KC + (kk + 4 * tt) * 72 + ks * 32 + 8 * g);
#pragma unroll
              for (int dt = 0; dt < 4; ++dt) vf[dt] = *(const bf16x8*)(VC + (16 * dt + c) * 264 + st * 32 + 8 * g); }
#pragma unroll
            for (int i = 0; i < 4; ++i) { float sv[8]; ATT_QK(i, kf); ATT_SOFTMAX_PV(i, vf, st == 0); }
        }
#pragma unroll 1
        for (int t = 0; t < nrow; ++t) {
            const int rho = rlo + t; const bf16_t* slot = RING + (t & 1) * SLOT;
            u32x4 kn, vn; const bool more = t + 1 < nrow;
            if (more) { kn = *(const u32x4*)(ksrc + (size_t)(rho + 1) * 64 * D); vn = *(const u32x4*)(vsrc + (rho + 1) * 64); }
            { const int kk = kc0 + 8 * (c >> 2) + (c & 3);
#pragma unroll
              for (int tt = 0; tt < 2; ++tt)
#pragma unroll
                  for (int ks = 0; ks < 2; ++ks) kf[tt][ks] = *(const bf16x8*)(slot + (kk + 4 * tt) * 72 + ks * 32 + 8 * g);
#pragma unroll
              for (int dt = 0; dt < 4; ++dt) vf[dt] = *(const bf16x8*)(slot + 64 * 72 + (16 * dt + c) * 72 + kc0 + 8 * g); }
#pragma unroll
            for (int i = 0; i < 4; ++i) {
                const int r = R0 + 4 * rh + i, r0 = min(max(r - 4, 0), 56);
                if (rho >= r0 && rho < r0 + 8) {
                    const float* rb = relw + 48 + (rho - r + 7) * 31 + boff;
                    float sv[8]; ATT_QK(i, kf);
#pragma unroll
                    for (int j = 0; j < 8; ++j) sv[j] = sel_mask(-1e30f, sv[j] + rb[j], wm[j]);
                    ATT_SOFTMAX_PV(i, vf, false);
                }
            }
            if (more) { bf16_t* nslot = RING + ((t + 1) & 1) * SLOT; *(u32x4*)(nslot + skey * 72 + sch * 8) = kn; *(u32x4*)(nslot + 64 * 72 + skey * 72 + sch * 8) = vn; }
            __syncthreads();
        }
#pragma unroll
        for (int i = 0; i < 4; ++i) { const float il = 1.f / __shfl(OL[i][0], c);
#pragma unroll
            for (int dt = 0; dt < 4; ++dt) { const size_t oi = (size_t)(b * T + (R0 + 4 * rh + i) * 64 + 16 * jb + c) * D + h * 64 + 16 * dt + 4 * g; if (OUTP_FP8) { const f32x4 ov = O[i][dt] * (il * OSCALE); *(unsigned*)((fp8_t*)p.o + oi) = pk4f8(ov.x, ov.y, ov.z, ov.w); } else st4bf(p.o + oi, O[i][dt] * il); } }
    }
    for (int t2 = gw; t2 < NB * 16 * 16; t2 += ngw) {
        const int b = t2 >> 8, h = (t2 >> 4) & 15, qrow0 = NL + b * CT + (t2 & 15) * 16, ctx0 = NL + b * CT;
        bf16x8 qf[1][2];
#pragma unroll
        for (int ks = 0; ks < 2; ++ks) qf[0][ks] = __builtin_nontemporal_load((const bf16x8*)(p.q + (size_t)(qrow0 + c) * D + h * 64 + ks * 32 + 8 * g));
        f32x4 O[1][4], OL[1], negm[1];
        negm[0] = (f32x4){0.f, 0.f, 0.f, 0.f}; OL[0] = (f32x4){0.f, 0.f, 0.f, 0.f};
#pragma unroll
        for (int dt = 0; dt < 4; ++dt) O[0][dt] = (f32x4){0.f, 0.f, 0.f, 0.f};
        bf16x8 kfA[2][2], vfA[4], kfB[2][2], vfB[4];
        ATT_LOADKV(ctx0, kfA, vfA);
        for (int st = 0; st < 8; st += 2) {
            ATT_LOADKV(ctx0 + (st + 1) * 32, kfB, vfB);
            { float sv[8]; ATT_QK(0, kfA); ATT_SOFTMAX_PV(0, vfA, st == 0); }
            { const int nx = (st + 2 < 8) ? ctx0 + (st + 2) * 32 : ctx0; ATT_LOADKV(nx, kfA, vfA); }
            { float sv[8]; ATT_QK(0, kfB); ATT_SOFTMAX_PV(0, vfB, false); }
        }
        const float il = 1.f / __shfl(OL[0][0], c);
#pragma unroll
        for (int dt = 0; dt < 4; ++dt) { const size_t oi = (size_t)(qrow0 + c) * D + h * 64 + 16 * dt + 4 * g; if (OUTP_FP8) { const f32x4 ov = O[0][dt] * (il * OSCALE); *(unsigned*)((fp8_t*)p.o + oi) = pk4f8(ov.x, ov.y, ov.z, ov.w); } else st4bf(p.o + oi, O[0][dt] * il); }
    }
}
#undef ATT_SOFTMAX_PV
#undef ATT_THR
#undef ATT_QK
#undef ATT_LOADKV

template <int l> __device__ __forceinline__ void phase_post_mixer(const P& p, char* smem) {
    float* wr = (float*)smem;
    for (int idx = tid_(); idx < 1024 * 16 / 4; idx += NTHR) { const int k = idx >> 2, e4 = idx & 3; ((f32x4*)wr)[((k & 3) * 4 + e4) * 256 + (k >> 2)] = ((const f32x4*)(p.moe_wr + (size_t)l * 1024 * 16))[idx]; }
    __syncthreads();
    const int lane = tid_() & 63, gw = blockIdx.x * NWAVE + (tid_() >> 6), ngw = gridDim.x * NWAVE;
    const int nrow = l == 0 ? R : NL; const int npw = (nrow + ngw - 1) / ngw;
    f32x4 g1v[4], g2v[4], gtv[4], shv[4], scv[4];
#pragma unroll
    for (int j = 0; j < 4; ++j) { g1v[j] = ((const f32x4*)(p.norm_g + (l * 4 + 1) * D))[lane + 64 * j]; g2v[j] = ((const f32x4*)(p.norm_g + (l * 4 + 2) * D))[lane + 64 * j]; }
    int scur = -1;
    int row = gw * npw; const int rend = min(nrow, row + npw);
#define PM_XIN(r) ((r) < NL ? p.x + (size_t)(r) * D : p.ctx + (size_t)((r) - NL) * D)
    while (row < rend) {
        const int s = row < NL ? (row >> 12) : 8;
        const bool two = (row + 1 < rend) && (((row + 1) < NL ? ((row + 1) >> 12) : 8) == s);
        const int row1 = two ? row + 1 : row;
        const int rr[2] = {row, row1};
        u32x2 yw[2][4]; f32x4 xv[2][4];
#pragma unroll
        for (int r = 0; r < 2; ++r)
#pragma unroll
            for (int j = 0; j < 4; ++j) { yw[r][j] = __builtin_nontemporal_load((const u32x2*)(p.y + (size_t)rr[r] * D) + lane + 64 * j);
                if (l == 0) xv[r][j] = __builtin_nontemporal_load((const f32x4*)PM_XIN(rr[r]) + lane + 64 * j);
                else { const u32x2 w = __builtin_nontemporal_load((const u32x2*)(p.xs + (size_t)rr[r] * D) + lane + 64 * j); xv[r][j] = (f32x4){bflo(w.x), bfhi(w.x), bflo(w.y), bfhi(w.y)}; } }
        if (s != scur) { const float* md = p.mod + (size_t)(l * 9 + s) * 6144; scur = s;
#pragma unroll
            for (int j = 0; j < 4; ++j) { gtv[j] = ((const f32x4*)(md + 2048))[lane + 64 * j]; shv[j] = ((const f32x4*)(md + 3072))[lane + 64 * j]; scv[j] = ((const f32x4*)(md + 4096))[lane + 64 * j]; } }
        f32x4 yv[2][4]; float ss[2] = {0.f, 0.f};
#pragma unroll
        for (int r = 0; r < 2; ++r)
#pragma unroll
            for (int j = 0; j < 4; ++j) { const u32x2 w = yw[r][j]; yv[r][j] = (f32x4){bflo(w.x), bfhi(w.x), bflo(w.y), bfhi(w.y)};
                ss[r] += yv[r][j].x * yv[r][j].x + yv[r][j].y * yv[r][j].y + yv[r][j].z * yv[r][j].z + yv[r][j].w * yv[r][j].w; }
        ss[0] = row_sum16(ss[0]); ss[1] = row_sum16(ss[1]); ss[0] = x16_sum(ss[0]); ss[1] = x16_sum(ss[1]); ss[0] = x32_sum(ss[0]); ss[1] = x32_sum(ss[1]);
        float rs[2], s2[2] = {0.f, 0.f};
#pragma unroll
        for (int r = 0; r < 2; ++r) rs[r] = __builtin_amdgcn_rsqf(ss[r] * (1.f / D) + EPS);
#pragma unroll
        for (int r = 0; r < 2; ++r) { bf16_t* xo = (p.dry ? (bf16_t*)p.dryx : p.xs) + (size_t)rr[r] * D;
#pragma unroll
            for (int j = 0; j < 4; ++j) { const int ci = lane + 64 * j;
                xv[r][j] = xv[r][j] + gtv[j] * (yv[r][j] * rs[r] * g1v[j]); { u32x2 w; w.x = pk2(xv[r][j].x, xv[r][j].y); w.y = pk2(xv[r][j].z, xv[r][j].w); ((u32x2*)xo)[ci] = w; }
                s2[r] += xv[r][j].x * xv[r][j].x + xv[r][j].y * xv[r][j].y + xv[r][j].z * xv[r][j].z + xv[r][j].w * xv[r][j].w; } }
        s2[0] = row_sum16(s2[0]); s2[1] = row_sum16(s2[1]); s2[0] = x16_sum(s2[0]); s2[1] = x16_sum(s2[1]); s2[0] = x32_sum(s2[0]); s2[1] = x32_sum(s2[1]);
        float rs2[2];
#pragma unroll
        for (int r = 0; r < 2; ++r) rs2[r] = __builtin_amdgcn_rsqf(s2[r] * (1.f / D) + EPS);
        float lg[2][16];
#pragma unroll
        for (int r = 0; r < 2; ++r)
#pragma unroll
            for (int e = 0; e < 16; ++e) lg[r][e] = 0.f;
#pragma unroll
        for (int j = 0; j < 4; ++j) { const int ci = lane + 64 * j;
            f32x4 hv[2];
#pragma unroll
            for (int r = 0; r < 2; ++r) { hv[r] = xv[r][j] * rs2[r] * g2v[j] * (scv[j] + 1.f) + shv[j];
                ((unsigned*)(p.h28 + (size_t)rr[r] * D))[ci] = pk4f8(hv[r].x, hv[r].y, hv[r].z, hv[r].w); }
#pragma unroll
            for (int i = 0; i < 4; ++i) {
#pragma unroll
                for (int e4 = 0; e4 < 4; ++e4) { const f32x4 wv = ((const f32x4*)wr)[(i * 4 + e4) * 256 + ci];
#pragma unroll
                    for (int r = 0; r < 2; ++r) { const float hx = hv[r][i]; lg[r][4 * e4] += hx * wv.x; lg[r][4 * e4 + 1] += hx * wv.y; lg[r][4 * e4 + 2] += hx * wv.z; lg[r][4 * e4 + 3] += hx * wv.w; } } }
            asm volatile("" ::: "memory"); }
        float r1[2];
#pragma unroll
        for (int r = 0; r < 2; ++r) { float r8[8], r4[4], r2[2];
#pragma unroll
            for (int e = 0; e < 8; ++e) { auto q2 = __builtin_amdgcn_permlane32_swap(__float_as_uint(lg[r][e]), __float_as_uint(lg[r][e + 8]), false, false); r8[e] = __uint_as_float(q2[0]) + __uint_as_float(q2[1]); }
#pragma unroll
            for (int e = 0; e < 4; ++e) { auto q2 = __builtin_amdgcn_permlane16_swap(__float_as_uint(r8[e]), __float_as_uint(r8[e + 4]), false, false); r4[e] = __uint_as_float(q2[0]) + __uint_as_float(q2[1]); }
            { const bool hi = lane & 8;
#pragma unroll
              for (int e = 0; e < 2; ++e) { const float keep = hi ? r4[e + 2] : r4[e], send = hi ? r4[e] : r4[e + 2]; r2[e] = keep + dpp_<0x128>(send); } }
            { const bool hi = lane & 4; const float keep = hi ? r2[1] : r2[0], send = hi ? r2[0] : r2[1]; r1[r] = keep + __shfl_xor(send, 4); }
            r1[r] += dpp_<0xB1>(r1[r]); r1[r] += dpp_<0x4E>(r1[r]); }
        const int eidx = ((lane >> 5) & 1) * 8 + ((lane >> 4) & 1) * 4 + ((lane >> 3) & 1) * 2 + ((lane >> 2) & 1);
#pragma unroll
        for (int r = 0; r < 2; ++r) { float mx = r1[r];
            mx = fmaxf(mx, dpp_<0x124>(mx)); mx = fmaxf(mx, dpp_<0x128>(mx)); mx = x16_max(mx); mx = x32_max(mx);
            const float ex = __expf(r1[r] - mx); float sum = ex;
            sum += dpp_<0x124>(sum); sum += dpp_<0x128>(sum); sum = x16_sum(sum); sum = x32_sum(sum);
            if ((lane & 3) == 0) p.aff[(size_t)rr[r] * 16 + eidx] = ex / sum; }
        row += two ? 2 : 1;
    }
#undef PM_XIN
}

__device__ __forceinline__ void phase_topk(const P& p, int l, char* smem) {
    unsigned* key = (unsigned*)smem;
    unsigned* cntw = key + 4096;
    int* wsum = (int*)(cntw + 32);
    int* rowsel = wsum + 16;
    const int tid = tid_(), lane = tid & 63, wid = tid >> 6;
    const int nset = l == 0 ? 16 : 8;
    const int cap_tot = l == 0 ? CAP0 : CAP1;
    for (int task = blockIdx.x; task < nset * NE; task += gridDim.x) {
        const int set = task / NE, e = task % NE;
        const bool lat = set < 8; const int n = lat ? T : CT, cap = lat ? CAPL : CAPC;
        const int row0 = lat ? set * T : NL + (set - 8) * CT;
        const int slot0 = lat ? set * CAPL : NB * CAPL + (set - 8) * CAPC;
        for (int i = tid; i < n; i += NTHR) key[i] = __float_as_uint(p.aff[(size_t)(row0 + i) * 16 + e]);
        __syncthreads();
        unsigned kreg[8]; const int nk = lat ? 8 : 1; const bool kact = lat || tid < CT;
#pragma unroll
        for (int j = 0; j < 8; ++j) kreg[j] = (kact && j < nk) ? key[tid + j * NTHR] : 0u;
        unsigned Tv = 0u; int par = 0;
        for (int bit = 30; bit >= 0; bit -= 2) {
            const unsigned bh = 1u << bit, bl = bit > 0 ? (1u << (bit - 1)) : 0u;
            const unsigned c1 = Tv | bl, c2 = Tv | bh, c3 = Tv | bh | bl; int n1 = 0, n2 = 0, n3 = 0;
#pragma unroll
            for (int j = 0; j < 8; ++j) { n1 += (kreg[j] >= c1) ? 1 : 0; n2 += (kreg[j] >= c2) ? 1 : 0; n3 += (kreg[j] >= c3) ? 1 : 0; }
            const float pa = wave_sum((float)(n1 + 1024 * n2)), pb = wave_sum((float)n3);
            if (lane == 0) { cntw[par * 16 + wid] = (unsigned)pa; cntw[par * 16 + 8 + wid] = (unsigned)pb; }
            __syncthreads();
            int t1 = 0, t2 = 0, t3 = 0;
#pragma unroll
            for (int w2 = 0; w2 < 8; ++w2) { const unsigned a = cntw[par * 16 + w2]; t1 += (int)(a & 1023u); t2 += (int)(a >> 10); t3 += (int)cntw[par * 16 + 8 + w2]; }
            if (bl == 0u) { if (t2 >= cap) Tv = c2; }
            else if (t3 >= cap) Tv = c3; else if (t2 >= cap) Tv = c2; else if (t1 >= cap) Tv = c1;
            par ^= 1;
        }
        __syncthreads();
        const int per = lat ? 8 : 1; const bool act = lat || tid < CT; const int i0 = tid * per;
        int ngt = 0, neq = 0;
        if (act) for (int j = 0; j < per; ++j) { const unsigned kv = key[i0 + j]; ngt += kv > Tv; neq += kv == Tv; }
        const int ps_ = (int)wave_scan_add((float)(ngt + 1024 * neq)); int sg = ps_ & 1023, se = ps_ >> 10;
        if (lane == 63) { wsum[wid] = sg; wsum[8 + wid] = se; }
        __syncthreads();
        int og = 0, oe = 0, totg = 0;
#pragma unroll
        for (int w2 = 0; w2 < 8; ++w2) { const int a = wsum[w2], b2 = wsum[8 + w2]; if (w2 < wid) { og += a; oe += b2; } totg += a; }
        int pg = og + sg - ngt, pe = oe + se - neq;
        const int need_eq = cap - totg;
        if (act) for (int j = 0; j < per; ++j) {
            const unsigned kv = key[i0 + j]; const int row = row0 + i0 + j; int slot = -1;
            if (kv > Tv) { slot = pg + min(pe, need_eq); ++pg; }
            else if (kv == Tv) { if (pe < need_eq) slot = pg + pe; ++pe; }
            p.inv[(size_t)row * 16 + e] = slot >= 0 ? slot0 + slot : -1;
            if (slot >= 0) { rowsel[slot] = row; p.list[e * CAP0 + slot0 + slot] = row; p.gatev[e * CAP0 + slot0 + slot] = __uint_as_float(kv); }
        }
        __syncthreads();
        __syncthreads();
    }
}

template <int l> __device__ __forceinline__ void phase_post_ffn(const P& p) {
    const int lane = tid_() & 63, gw = blockIdx.x * NWAVE + (tid_() >> 6), ngw = gridDim.x * NWAVE;
    const int nrow = l == 0 ? R : NL; const int cap_tot = l == 0 ? CAP0 : CAP1; const int npw = (nrow + ngw - 1) / ngw;
    f32x4 g3v[4], gnv[4], gtv[4], shv[4], scv[4];
#pragma unroll
    for (int j = 0; j < 4; ++j) { g3v[j] = ((const f32x4*)(p.norm_g + (l * 4 + 3) * D))[lane + 64 * j]; if (l == 0) gnv[j] = ((const f32x4*)(p.norm_g + ((l + 1) * 4 + 0) * D))[lane + 64 * j]; }
    int scur = -1;
    int row = gw * npw; const int rend = min(nrow, row + npw);
#define PF_GATHER(invreg, yd, cnt, rest) do { unsigned long long m_ = __ballot((invreg) >= 0); cnt = 0; \
        _Pragma("unroll") for (int k = 0; k < 4; ++k) { if (m_ != 0ull) { const int e_ = __builtin_ctzll(m_); m_ &= m_ - 1; const int sl_ = __builtin_amdgcn_readlane((invreg), e_); \
            const u32x2* src_ = (const u32x2*)(p.XgY + ((size_t)e_ * cap_tot + sl_) * D); _Pragma("unroll") for (int j = 0; j < 4; ++j) yd[k][j] = __builtin_nontemporal_load(src_ + lane + 64 * j); cnt = k + 1; } } \
        rest = m_; } while (0)
    u32x2 xr[4], yr[4][4]; int ycnt = 0; unsigned long long yrest = 0ull; int invc = -1, invn = -1;
    if (row < rend) { invc = (lane < 16) ? p.inv[(size_t)row * 16 + lane] : -1;
        if (row + 1 < rend) invn = (lane < 16) ? p.inv[(size_t)(row + 1) * 16 + lane] : -1;
#pragma unroll
        for (int j = 0; j < 4; ++j) xr[j] = __builtin_nontemporal_load((const u32x2*)(p.xs + (size_t)row * D) + lane + 64 * j);
        PF_GATHER(invc, yr, ycnt, yrest); }
    for (; row < rend; ++row) {
        u32x2 xrn[4], yrn[4][4]; int ycntn = 0; unsigned long long yrestn = 0ull; int invnn = -1;
        const bool hn = row + 1 < rend;
        if (hn) {
#pragma unroll
            for (int j = 0; j < 4; ++j) xrn[j] = __builtin_nontemporal_load((const u32x2*)(p.xs + (size_t)(row + 1) * D) + lane + 64 * j);
            PF_GATHER(invn, yrn, ycntn, yrestn);
            if (row + 2 < rend) invnn = (lane < 16) ? p.inv[(size_t)(row + 2) * 16 + lane] : -1; }
        f32x4 mv[4], xv[4];
#pragma unroll
        for (int j = 0; j < 4; ++j) mv[j] = (f32x4){0.f, 0.f, 0.f, 0.f};
#pragma unroll
        for (int k = 0; k < 4; ++k) if (k < ycnt) {
#pragma unroll
            for (int j = 0; j < 4; ++j) { const u32x2 w = yr[k][j]; mv[j] += (f32x4){bflo(w.x), bfhi(w.x), bflo(w.y), bfhi(w.y)}; } }
        while (yrest) {
            const int e = __builtin_ctzll(yrest); yrest &= yrest - 1; const int sl = __builtin_amdgcn_readlane(invc, e);
            const u32x2* src = (const u32x2*)(p.XgY + ((size_t)e * cap_tot + sl) * D);
#pragma unroll
            for (int j = 0; j < 4; ++j) { const u32x2 w = __builtin_nontemporal_load(src + lane + 64 * j); mv[j] += (f32x4){bflo(w.x), bfhi(w.x), bflo(w.y), bfhi(w.y)}; } }
#pragma unroll
        for (int j = 0; j < 4; ++j) xv[j] = (f32x4){bflo(xr[j].x), bfhi(xr[j].x), bflo(xr[j].y), bfhi(xr[j].y)};
        const int s = row < NL ? (row >> 12) : 8;
        if (s != scur) { const float* md = p.mod + (size_t)(l * 9 + s) * 6144; const float* md1 = p.mod + (size_t)(1 * 9 + s) * 6144; scur = s;
#pragma unroll
            for (int j = 0; j < 4; ++j) { gtv[j] = ((const f32x4*)(md + 5120))[lane + 64 * j]; if (l == 0) { shv[j] = ((const f32x4*)md1)[lane + 64 * j]; scv[j] = ((const f32x4*)(md1 + 1024))[lane + 64 * j]; } } }
        float ss = 0.f;
#pragma unroll
        for (int j = 0; j < 4; ++j) ss += mv[j].x * mv[j].x + mv[j].y * mv[j].y + mv[j].z * mv[j].z + mv[j].w * mv[j].w;
        ss = wave_sum(ss); const float rs = __builtin_amdgcn_rsqf(ss * (1.f / D) + EPS);
        float s2 = 0.f;
#pragma unroll
        for (int j = 0; j < 4; ++j) { const int ci = lane + 64 * j;
            xv[j] = xv[j] + gtv[j] * (mv[j] * rs * g3v[j]);
            if (l == 0) { u32x2 w; w.x = pk2(xv[j].x, xv[j].y); w.y = pk2(xv[j].z, xv[j].w); ((u32x2*)((p.dry ? (bf16_t*)p.dryx : p.xs) + (size_t)row * D))[ci] = w; }
            else __builtin_nontemporal_store(xv[j], (f32x4*)((p.dry ? p.dryx : p.out) + (size_t)row * D) + ci);
            s2 += xv[j].x * xv[j].x + xv[j].y * xv[j].y + xv[j].z * xv[j].z + xv[j].w * xv[j].w; }
        if (l == 0) {
            s2 = wave_sum(s2); const float rs2 = __builtin_amdgcn_rsqf(s2 * (1.f / D) + EPS);
#pragma unroll
            for (int j = 0; j < 4; ++j) { const int ci = lane + 64 * j;
                const f32x4 hv = xv[j] * rs2 * gnv[j] * (scv[j] + 1.f) + shv[j];
                if (MLIN_FP8) ((unsigned*)(p.h8 + (size_t)row * D))[ci] = pk4f8(hv.x, hv.y, hv.z, hv.w);
                else { u32x2 w; w.x = pk2(hv.x, hv.y); w.y = pk2(hv.z, hv.w); ((u32x2*)(p.h + (size_t)row * D))[ci] = w; } }
        }
        if (hn) { invc = invn; invn = invnn; ycnt = ycntn; yrest = yrestn;
#pragma unroll
            for (int j = 0; j < 4; ++j) { xr[j] = xrn[j];
#pragma unroll
                for (int k = 0; k < 4; ++k) yr[k][j] = yrn[k][j]; } }
    }
#undef PF_GATHER
}

constexpr int IST = 72;
constexpr int IMG_Q = 0, IMG_K = 64 * IST, IMG_KT = 2 * 64 * IST, IMG_VT = 3 * 64 * IST, IMG_ELEMS = 4 * 64 * IST;
constexpr int CT_ROWS = 80;
__device__ __forceinline__ int tswz(int row, int blk) { return ((blk ^ ((row >> 3) & 7)) << 3); }
__device__ __forceinline__ void phase_mscan(const P& p, char* smem) {
    bf16_t* img = (bf16_t*)smem;
    bf16_t* SG = img + 2 * IMG_ELEMS;
    bf16_t* CTi = SG + 64 * IST;
    float* scal = (float*)(CTi + 2 * CT_ROWS * IST);
    float* decs = scal + 2 * 5 * 64;
    const int tid = tid_(), lane = tid & 63, wid = tid >> 6, g0_ = lane >> 4, c0_ = lane & 15;
    for (int task = blockIdx.x; task < NB * 16 * 2; task += gridDim.x) {
        const int b = task >> 5, G = (task >> 1) & 15, vh = task & 1, dir = G >> 3, head = G & 7;
        bf16_t* hout = dir ? p.hb : p.hf;
        for (int i = tid; i < 2 * CT_ROWS * IST; i += NTHR) CTi[i] = 0;
        f32x4 accC[4];
#pragma unroll
        for (int tc = 0; tc < 4; ++tc) accC[tc] = (f32x4){0.f, 0.f, 0.f, 0.f};
        float nreg = 0.f, mstate = -1e30f;
        u32x4 sq0[2], sk0[2], sv0[2];
        auto rowof = [&](int cc, int j) -> int { const bool isc = cc < 4; const int Tn = isc ? CT : T; const int pp = (isc ? cc : cc - 4) * 64 + j; const int t = dir ? Tn - 1 - pp : pp; return (isc ? NL + b * CT : b * T) + t; };
#define MS_LOAD(cc, stq, stk, stv) do { _Pragma("unroll") for (int u = 0; u < 2; ++u) { const int pc = (tidl - 256) + 256 * u; const int j = pc >> 3, ch = pc & 7; const size_t row = (size_t)rowof(cc, j); \
            stq[u] = *(const u32x4*)(p.qm + row * 512 + head * 64 + ch * 8); stk[u] = *(const u32x4*)(p.km + row * 512 + head * 64 + ch * 8); \
            stv[u] = *(const u32x4*)(p.vm + row * D + head * 128 + vh * 64 + ch * 8); } } while (0)
#define MS_STORE(buf, stq, stk, stv) do { bf16_t* im = img + (buf) * IMG_ELEMS; _Pragma("unroll") for (int u = 0; u < 2; ++u) { const int pc = (tidl - 256) + 256 * u; const int j = pc >> 3, ch = pc & 7; \
            *(u32x4*)(im + IMG_Q + j * IST + ch * 8) = stq[u]; *(u32x4*)(im + IMG_K + j * IST + ch * 8) = stk[u]; \
            const unsigned kw[4] = {stk[u].x, stk[u].y, stk[u].z, stk[u].w}; const unsigned vw[4] = {stv[u].x, stv[u].y, stv[u].z, stv[u].w}; \
            _Pragma("unroll") for (int e2 = 0; e2 < 4; ++e2) { im[IMG_KT + (ch * 8 + 2 * e2) * IST + tswz(ch * 8, j >> 3) + (j & 7)] = (bf16_t)(kw[e2] & 0xffffu); im[IMG_KT + (ch * 8 + 2 * e2 + 1) * IST + tswz(ch * 8, j >> 3) + (j & 7)] = (bf16_t)(kw[e2] >> 16); \
                im[IMG_VT + (ch * 8 + 2 * e2) * IST + tswz(ch * 8, j >> 3) + (j & 7)] = (bf16_t)(vw[e2] & 0xffffu); im[IMG_VT + (ch * 8 + 2 * e2 + 1) * IST + tswz(ch * 8, j >> 3) + (j & 7)] = (bf16_t)(vw[e2] >> 16); } } } while (0)
#define MS_GLOAD(cc, g_ig, g_lf) do { const size_t row = (size_t)rowof(cc, lane); g_ig = p.gates[row * 32 + dir * 8 + head]; g_lf = p.gates[row * 32 + 16 + dir * 8 + head]; } while (0)
#define MS_SCAL(cc, buf, g_ig, g_lf) do { const float ig = g_ig, lf = g_lf; \
            const float bc = wave_scan_add(lf); \
            const float av = ig - bc; const float pm = wave_scan_max(av); \
            const float bend = __uint_as_float((unsigned)__builtin_amdgcn_readlane((int)__float_as_uint(bc), 63)), pm63 = __uint_as_float((unsigned)__builtin_amdgcn_readlane((int)__float_as_uint(pm), 63)); const float mnext = fmaxf(bend + mstate, bend + pm63); const float Mt = fmaxf(pm, mstate); \
            float* sb = scal + (buf) * 5 * 64; sb[lane] = av; sb[64 + lane] = Mt; sb[128 + lane] = __expf(mstate - Mt); sb[192 + lane] = __expf(-(bc + Mt)); sb[256 + lane] = __expf(bend + av - mnext); \
            if (lane == 0) decs[buf] = __expf(bend + mstate - mnext); mstate = mnext; } while (0)
        float gi0 = 0.f, gl0 = 0.f;
        int tidl = tid;
        if (wid >= 4) { MS_LOAD(0, sq0, sk0, sv0); }
        if (wid == 7) { MS_GLOAD(0, gi0, gl0); }
        __syncthreads();
        if (wid >= 4) { MS_STORE(0, sq0, sk0, sv0); MS_LOAD(1, sq0, sk0, sv0); }
        if (wid == 7) { MS_SCAL(0, 0, gi0, gl0); MS_GLOAD(1, gi0, gl0); }
        __syncthreads();
        for (int cc = 0; cc < 68; ++cc) {
            const int cur = cc & 1, nxt = cur ^ 1;
            int c_ = c0_, g_ = g0_; tidl = tid; asm volatile("" : "+v"(c_), "+v"(g_), "+v"(tidl));
            const bf16_t* im = img + cur * IMG_ELEMS; const float* sb = scal + cur * 5 * 64;
            if (wid >= 4) {
                if (cc + 1 < 68) { MS_STORE(nxt, sq0, sk0, sv0); if (wid == 7) { MS_SCAL(cc + 1, nxt, gi0, gl0); } }
                if (cc + 2 < 68) { MS_LOAD(cc + 2, sq0, sk0, sv0); if (wid == 7) { MS_GLOAD(cc + 2, gi0, gl0); } }
                const int wq = wid - 4; const float decay = decs[cur];
#pragma unroll
                for (int tc = 0; tc < 4; ++tc) accC[tc] = accC[tc] * decay;
#pragma unroll
                for (int ks = 0; ks < 2; ++ks) {
                    const u32x4 kraw = *(const u32x4*)(im + IMG_KT + (16 * wq + c_) * IST + tswz(16 * wq + c_, 4 * ks + g_));
                    const f32x4 w0 = *(const f32x4*)(sb + 256 + 32 * ks + 8 * g_), w1 = *(const f32x4*)(sb + 256 + 32 * ks + 8 * g_ + 4);
                    float t8[8] = {bflo(kraw.x) * w0.x, bfhi(kraw.x) * w0.y, bflo(kraw.y) * w0.z, bfhi(kraw.y) * w0.w, bflo(kraw.z) * w1.x, bfhi(kraw.z) * w1.y, bflo(kraw.w) * w1.z, bfhi(kraw.w) * w1.w};
                    const bf16x8 kwf = pack8(t8);
#pragma unroll
                    for (int tc = 0; tc < 4; ++tc) { const bf16x8 vtf = *(const bf16x8*)(im + IMG_VT + (16 * tc + c_) * IST + tswz(16 * tc + c_, 4 * ks + g_)); accC[tc] = MFMA16(kwf, vtf, accC[tc]); }
                }
                bf16_t* ctn = CTi + nxt * CT_ROWS * IST;
#pragma unroll
                for (int tc = 0; tc < 4; ++tc) { u32x2 w; w.x = pk2(accC[tc].x, accC[tc].y); w.y = pk2(accC[tc].z, accC[tc].w); *(u32x2*)(ctn + (16 * tc + c_) * IST + 16 * wq + 4 * g_) = w; }
                if (wid == 4) {
                    float sacc = 0.f;
#pragma unroll
                    for (int s8 = 0; s8 < 8; ++s8) { const u32x4 kr = *(const u32x4*)(im + IMG_KT + lane * IST + tswz(lane, s8)); const f32x4 w0 = *(const f32x4*)(sb + 256 + 8 * s8), w1 = *(const f32x4*)(sb + 256 + 8 * s8 + 4);
                        sacc += bflo(kr.x) * w0.x + bfhi(kr.x) * w0.y + bflo(kr.y) * w0.z + bfhi(kr.y) * w0.w + bflo(kr.z) * w1.x + bfhi(kr.z) * w1.y + bflo(kr.w) * w1.z + bfhi(kr.w) * w1.w; }
                    nreg = nreg * decay + sacc; ctn[64 * IST + lane] = f2bf(nreg);
                }
            } else if (cc >= 4) {
                const int tr = wid; const bf16_t* ctc = CTi + cur * CT_ROWS * IST; const int t = 16 * tr + c_;
                bf16x8 qB[2], kfr[4][2], vtf[4][2], ctf[4][2], nf[2];
#pragma unroll
                for (int ks = 0; ks < 2; ++ks) { qB[ks] = *(const bf16x8*)(im + IMG_Q + t * IST + 32 * ks + 8 * g_); nf[ks] = *(const bf16x8*)(ctc + (64 + c_) * IST + 32 * ks + 8 * g_); }
#pragma unroll
                for (int ts = 0; ts < 4; ++ts)
#pragma unroll
                    for (int ks = 0; ks < 2; ++ks) if (ts <= tr) kfr[ts][ks] = *(const bf16x8*)(im + IMG_K + (16 * ts + c_) * IST + 32 * ks + 8 * g_);
#pragma unroll
                for (int dvt = 0; dvt < 4; ++dvt)
#pragma unroll
                    for (int ks = 0; ks < 2; ++ks) { const int dvr = 16 * dvt + c_;
                        const u32x2 v0 = *(const u32x2*)(im + IMG_VT + dvr * IST + tswz(dvr, 4 * ks + (g_ >> 1)) + 4 * (g_ & 1));
                        const u32x2 v1 = *(const u32x2*)(im + IMG_VT + dvr * IST + tswz(dvr, 4 * ks + 2 + (g_ >> 1)) + 4 * (g_ & 1));
                        u32x4 vw; vw.x = v0.x; vw.y = v0.y; vw.z = v1.x; vw.w = v1.y; vtf[dvt][ks] = __builtin_bit_cast(bf16x8, vw);
                        ctf[dvt][ks] = *(const bf16x8*)(ctc + dvr * IST + 32 * ks + 8 * g_); }
                const float Mt = sb[64 + t], wint = sb[128 + t], en = sb[192 + t];
                f32x4 a4[4];
#pragma unroll
                for (int ts = 0; ts < 4; ++ts) a4[ts] = *(const f32x4*)(sb + 16 * ts + 4 * g_);
                unsigned pb[4][2]; float rsum = 0.f;
#pragma unroll
                for (int ts = 0; ts < 4; ++ts) {
                    pb[ts][0] = 0u; pb[ts][1] = 0u;
                    if (ts <= tr) {
                        f32x4 s0 = (f32x4){0.f, 0.f, 0.f, 0.f};
#pragma unroll
                        for (int ks = 0; ks < 2; ++ks) s0 = MFMA16(kfr[ts][ks], qB[ks], s0);
                        float pv[4];
#pragma unroll
                        for (int i = 0; i < 4; ++i) { const int sidx = 16 * ts + 4 * g_ + i; pv[i] = (sidx <= t) ? s0[i] * __expf(a4[ts][i] - Mt) : 0.f; rsum += pv[i]; }
                        pb[ts][0] = pk2(pv[0], pv[1]); pb[ts][1] = pk2(pv[2], pv[3]);
                    }
                }
                rsum = x16_sum(rsum); rsum = x32_sum(rsum);
                f32x4 qn4 = (f32x4){0.f, 0.f, 0.f, 0.f};
#pragma unroll
                for (int ks = 0; ks < 2; ++ks) qn4 = MFMA16(nf[ks], qB[ks], qn4);
                const float qn = __shfl(qn4[0], c_);
                const float den = rsum + wint * qn; const float inv_den = __builtin_amdgcn_rcpf(fmaxf(fabsf(den), en));
                bf16x8 pB[2];
#pragma unroll
                for (int ks = 0; ks < 2; ++ks) { u32x4 w; w.x = pb[2 * ks][0]; w.y = pb[2 * ks][1]; w.z = pb[2 * ks + 1][0]; w.w = pb[2 * ks + 1][1]; pB[ks] = __builtin_bit_cast(bf16x8, w); }
                const size_t orow = (size_t)rowof(cc, t);
#pragma unroll
                for (int dvt = 0; dvt < 4; ++dvt) {
                    f32x4 nin = (f32x4){0.f, 0.f, 0.f, 0.f}, nit = nin;
#pragma unroll
                    for (int ks = 0; ks < 2; ++ks) { nit = MFMA16(ctf[dvt][ks], qB[ks], nit); nin = MFMA16(vtf[dvt][ks], pB[ks], nin); }
                    st4bf(hout + orow * D + head * 128 + vh * 64 + 16 * dvt + 4 * g_, (nin + nit * wint) * inv_den);
                }
            }
            asm volatile("s_waitcnt lgkmcnt(0)" ::: "memory"); __builtin_amdgcn_s_barrier(); asm volatile("" ::: "memory");
        }
#undef MS_LOAD
#undef MS_STORE
#undef MS_SCAL
#undef MS_GLOAD
    }
}

__device__ __forceinline__ void phase_readout(const P& p) {
    const int lane = tid_() & 63, gw = blockIdx.x * NWAVE + (tid_() >> 6), ngw = gridDim.x * NWAVE;
    for (int row = gw; row < NL; row += ngw) {
        float hs[16]; float ss = 0.f;
#pragma unroll
        for (int u = 0; u < 2; ++u) { const u32x4 a = __builtin_nontemporal_load((const u32x4*)(p.hf + (size_t)row * D) + 2 * lane + u), b2 = __builtin_nontemporal_load((const u32x4*)(p.hb + (size_t)row * D) + 2 * lane + u);
            const unsigned aw[4] = {a.x, a.y, a.z, a.w}, bw[4] = {b2.x, b2.y, b2.z, b2.w};
#pragma unroll
            for (int e = 0; e < 4; ++e) { const float v0 = bflo(aw[e]) + bflo(bw[e]), v1 = bfhi(aw[e]) + bfhi(bw[e]); hs[8 * u + 2 * e] = v0; hs[8 * u + 2 * e + 1] = v1; ss += v0 * v0 + v1 * v1; } }
        ss += dpp_<0xB1>(ss); ss += dpp_<0x4E>(ss); ss += dpp_<0x141>(ss);
        const float rs = __builtin_amdgcn_rsqf(ss * (1.f / 128.f) + EPS);
#pragma unroll
        for (int u = 0; u < 2; ++u) { const u32x4 ov = __builtin_nontemporal_load((const u32x4*)(p.om + (size_t)row * D) + 2 * lane + u); const unsigned ow[4] = {ov.x, ov.y, ov.z, ov.w}; u32x4 w; unsigned wo[4]; float av[8];
#pragma unroll
            for (int e = 0; e < 4; ++e) { const int col = 16 * lane + 8 * u + 2 * e; const float a0 = hs[8 * u + 2 * e] * rs * p.ml_normw[col] * sigmoidf_(bflo(ow[e])), a1 = hs[8 * u + 2 * e + 1] * rs * p.ml_normw[col + 1] * sigmoidf_(bfhi(ow[e])); wo[e] = pk2(a0, a1); av[2 * e] = a0 * OSCALE; av[2 * e + 1] = a1 * OSCALE; }
            if (OUTP_FP8) { u32x2 w8; w8.x = pk4f8(av[0], av[1], av[2], av[3]); w8.y = pk4f8(av[4], av[5], av[6], av[7]); ((u32x2*)((fp8_t*)p.ro + (size_t)row * D))[2 * lane + u] = w8; }
            else { w.x = wo[0]; w.y = wo[1]; w.z = wo[2]; w.w = wo[3]; ((u32x4*)(p.ro + (size_t)row * D))[2 * lane + u] = w; } }
    }
}


#define XB_TMO      128
#define XB_XCNT(j)  (256  + 64 * (j))
#define XB_XSUB(j)  (1280 + 64 * (j))
#define XB_XGEN(j)  (2304 + 64 * (j))
#define XB_TOP      3328
#define XB_TOPGEN   3392
#define XCD_BAR_WORDS 3456
#define XB_SPIN_CAP (1u << 18)
#define LAS __attribute__((address_space(3)))
__device__ __forceinline__ unsigned xb_ld(unsigned* p)              { return __hip_atomic_load(p, __ATOMIC_RELAXED, __HIP_MEMORY_SCOPE_AGENT); }
__device__ __forceinline__ unsigned xb_add(unsigned* p, unsigned v) { return __hip_atomic_fetch_add(p, v, __ATOMIC_RELAXED, __HIP_MEMORY_SCOPE_AGENT); }
__device__ __forceinline__ unsigned xb_xcc_id() { return (unsigned)__builtin_amdgcn_s_getreg((3 << 11) | 20) & 0xFu; }
#define XB_SPIN(cond, bar) do { unsigned _sp = 0; while (cond) { __builtin_amdgcn_s_sleep(1); \
    if ((++_sp & 255u) == 0u) { if (xb_ld(&(bar)[XB_TMO])) break; if (_sp > XB_SPIN_CAP) { atomicAdd(&(bar)[XB_TMO], 1u); break; } } } } while (0)
struct XcdBarrier { unsigned* bar; unsigned x; volatile LAS unsigned* st; };
__device__ __forceinline__ XcdBarrier xcd_barrier_post(unsigned* bar, volatile LAS unsigned* st) {
    XcdBarrier b; b.bar = bar; b.x = xb_xcc_id(); b.st = st;
    if (tid_() == 0) (void)xb_add(&bar[XB_XCNT(b.x)], 1u);
    return b;
}
__device__ __forceinline__ void xcd_barrier_complete(unsigned* bar, unsigned x, unsigned& nloc, unsigned& nx) {
    const unsigned G = gridDim.x * gridDim.y * gridDim.z;
    unsigned sum, cnt, mine, sp = 0u;
    for (;;) {
        sum = 0u; cnt = 0u; mine = 0u;
#pragma unroll
        for (unsigned j = 0; j < 16; ++j) { const unsigned c = xb_ld(&bar[XB_XCNT(j)]); sum += c; cnt += (c > 0u) ? 1u : 0u; mine = (j == x) ? c : mine; }
        if (sum == G) break;
        __builtin_amdgcn_s_sleep(1);
        if ((++sp & 255u) == 0u) { if (xb_ld(&bar[XB_TMO])) break; if (sp > XB_SPIN_CAP) { atomicAdd(&bar[XB_TMO], 1u); break; } }
    }
    nloc = mine > 0u ? mine : 1u; nx = cnt > 0u ? cnt : 1u;
}
__device__ __forceinline__ void xcd_barrier(const XcdBarrier& b) {
    asm volatile("s_waitcnt vmcnt(0)" ::: "memory");
    __syncthreads();
    if (tid_() == 0) {
        unsigned* bar = b.bar;
        __builtin_amdgcn_s_waitcnt(0);
        unsigned nloc = b.st[0], nx = b.st[1];
        if (nloc == 0u) { xcd_barrier_complete(bar, b.x, nloc, nx); b.st[0] = nloc; b.st[1] = nx; }
        const unsigned old = xb_add(&bar[XB_XSUB(b.x)], 1u);
        const unsigned gen = old / nloc;
        if (old + 1u == (gen + 1u) * nloc) {
            __builtin_amdgcn_fence(__ATOMIC_RELEASE, "agent");
            asm volatile("s_waitcnt vmcnt(0)" ::: "memory");
            const unsigned og = xb_add(&bar[XB_TOP], 1u);
            const unsigned tg = og / nx;
            if (og + 1u == (tg + 1u) * nx) xb_add(&bar[XB_TOPGEN], 1u);
            else XB_SPIN(xb_ld(&bar[XB_TOPGEN]) == tg, bar);
            __builtin_amdgcn_fence(__ATOMIC_ACQUIRE, "agent");
            xb_add(&bar[XB_XGEN(b.x)], 1u);
            asm volatile("s_waitcnt vmcnt(0)" ::: "memory");
        } else {
            XB_SPIN(xb_ld(&bar[XB_XGEN(b.x)]) == gen, bar);
            __builtin_amdgcn_fence(__ATOMIC_ACQUIRE, "agent");
            asm volatile("s_waitcnt vmcnt(0)" ::: "memory");
        }
    }
    __syncthreads();
}

constexpr int NPHASE = 19;
__global__ void __launch_bounds__(NTHR, 2) fwd_kernel(P p) {
    extern __shared__ __attribute__((aligned(16))) char smem[];
    cg::grid_group grid = cg::this_grid();
    PG8_LAS unsigned char* LDSP = (PG8_LAS unsigned char*)smem;
    volatile LAS unsigned* bst = (volatile LAS unsigned*)(LDSP + LDS_BYTES - 64);
    if (tid_() < 2) bst[tid_()] = 0u;
    __syncthreads();
    const XcdBarrier xbar = xcd_barrier_post(p.ctl, bst);
    if (p.ph_lo == 0x7fffffff) grid.sync();
#define GSYNC(k) do { xcd_barrier(xbar); } while (0)
#define CVFILL(base, limit, first_cu) convert_moe_fill(p, (float*)(smem + 20480) + (tid_() >> 6) * (64 * 65), (base), (limit), (first_cu))
#define CVFILL2(base, limit, first_cu, last_cu) convert_moe_fill(p, (float*)(smem + 20480) + (tid_() >> 6) * (64 * 65), (base), (limit), (first_cu), (last_cu))
    for (int i = 0; i < EXTRA_SYNCS; ++i) GSYNC(1);
    if (p.ph_lo <= 0 && 0 < p.ph_hi) { phase_mod(p, smem); __syncthreads(); convert_small_weights(p, smem); if (0 + 1 < p.ph_hi) GSYNC(0); }
    if (p.ph_lo <= 1 && 1 < p.ph_hi) { phase_norm0(p); if (1 + 1 < p.ph_hi) GSYNC(1); }
    if (p.ph_lo <= 2 && 2 < p.ph_hi) { { if (QKV_FP8) { SchedQKV S{(const char*)p.h8, (const char*)p.Wqkv8, 1, (int)gridDim.x, (int)blockIdx.x}; EpiQKV2 e{p.q, p.k, p.vT, WINV}; pg8::gemm_phase<true, false>(LDSP, D / 2, (size_t)128 * D, S, e); }
        else { SchedQKV S{(const char*)p.h, (const char*)p.Wqkv_t, 2, (int)gridDim.x, (int)blockIdx.x}; EpiQKV2 e{p.q, p.k, p.vT, 1.f}; pg8::gemm_phase<false, false>(LDSP, D, (size_t)128 * D * 2, S, e); } } CVFILL(0, 10000, 96); if (2 + 1 < p.ph_hi) GSYNC(2); }
    if (p.ph_lo <= 3 && 3 < p.ph_hi) { phase_attn(p, smem); if (3 + 1 < p.ph_hi) GSYNC(3); }
    if (p.ph_lo <= 4 && 4 < p.ph_hi) { { SchedPlain S{(const char*)p.o, (const char*)p.Wo0_t, R / 256, 4, OUTP_FP8 ? D : D * 2, (int)gridDim.x, (int)blockIdx.x}; EpiYb e{p.y, OUTP_FP8 ? WINV / OSCALE : 1.f}; if (OUTP_FP8) pg8::gemm_phase<true, false>(LDSP, D / 2, (size_t)128 * D, S, e); else pg8::gemm_phase<false, false>(LDSP, D, (size_t)128 * D * 2, S, e); } CVFILL(10000, 21000, 32); if (4 + 1 < p.ph_hi) GSYNC(4); }
    if (p.ph_lo <= 5 && 5 < p.ph_hi) { phase_post_mixer<0>(p, smem); if (5 + 1 < p.ph_hi) GSYNC(5); }
    if (p.ph_lo <= 6 && 6 < p.ph_hi) { phase_topk(p, 0, smem); CVFILL(21000, CV_NITL, 0); if (6 + 1 < p.ph_hi) GSYNC(6); }
    if (p.ph_lo <= 7 && 7 < p.ph_hi) { { SchedMoeUpG S{p.h28, p.Wgu8, p.list, CAP0 / 256, (int)gridDim.x, (int)blockIdx.x}; EpiHb e{p.H8}; pg8::gemm_phase<true, true>(LDSP, D / 2, (size_t)2048 * D, S, e); } if (7 + 1 < p.ph_hi) GSYNC(7); }
    if (p.ph_lo <= 8 && 8 < p.ph_hi) { { SchedMoeDown S{p.H8, p.Wd8, CAP0 / 256, (int)gridDim.x, (int)blockIdx.x}; EpiYMb e{p.XgY, p.gatev, CAP0 / 256}; pg8::gemm_phase<true, false>(LDSP, HID / 2, (size_t)128 * HID, S, e); } CVFILL(CV_NITL, CV_NITL + 15000, 64); if (8 + 1 < p.ph_hi) GSYNC(8); }
    if (p.ph_lo <= 9 && 9 < p.ph_hi) { phase_post_ffn<0>(p); if (9 + 1 < p.ph_hi) GSYNC(9); }
    if (p.ph_lo <= 10 && 10 < p.ph_hi) { { if (MLIN_FP8) { SchedPlain S{(const char*)p.h8, (const char*)p.Win8, R / 256, 13, D, (int)gridDim.x, (int)blockIdx.x}; EpiMLINb e{p.qm, p.km, p.vm, p.om, p.rope, p.gates, p.ml_bgate, WINV}; pg8::gemm_phase<true, false>(LDSP, D / 2, (size_t)128 * D, S, e); }
        else { SchedPlain S{(const char*)p.h, (const char*)p.Win_t, R / 256, 13, D * 2, (int)gridDim.x, (int)blockIdx.x}; EpiMLINb e{p.qm, p.km, p.vm, p.om, p.rope, p.gates, p.ml_bgate, 1.f}; pg8::gemm_phase<false, false>(LDSP, D, (size_t)128 * D * 2, S, e); } } if (10 + 1 < p.ph_hi) GSYNC(10); }
    if (p.ph_lo <= 11 && 11 < p.ph_hi) { phase_mscan(p, smem); if (11 + 1 < p.ph_hi) GSYNC(11); }
    if (p.ph_lo <= 12 && 12 < p.ph_hi) { phase_readout(p); if (12 + 1 < p.ph_hi) GSYNC(12); }
    if (p.ph_lo <= 13 && 13 < p.ph_hi) { { SchedPlain S{(const char*)p.ro, (const char*)p.Wo1_t, NL / 256, 4, OUTP_FP8 ? D : D * 2, (int)gridDim.x, (int)blockIdx.x}; EpiYb e{p.y, OUTP_FP8 ? WINV / OSCALE : 1.f}; if (OUTP_FP8) pg8::gemm_phase<true, false>(LDSP, D / 2, (size_t)128 * D, S, e); else pg8::gemm_phase<false, false>(LDSP, D, (size_t)128 * D * 2, S, e); } if (13 + 1 < p.ph_hi) GSYNC(13); }
    if (p.ph_lo <= 14 && 14 < p.ph_hi) { phase_post_mixer<1>(p, smem); if (14 + 1 < p.ph_hi) GSYNC(14); }
    if (p.ph_lo <= 15 && 15 < p.ph_hi) { phase_topk(p, 1, smem); CVFILL2(CV_NITL + 15000, CV_NITL + 20600, 128, 256); CVFILL2(CV_NITL + 20600, CV_NIT, 0, 128);        if (15 + 1 < p.ph_hi) GSYNC(15); }
    if (p.ph_lo <= 16 && 16 < p.ph_hi) { { SchedMoeUpG S{p.h28, p.Wgu8 + (size_t)NE * 4096 * D, p.list, CAP1 / 256, (int)gridDim.x, (int)blockIdx.x}; EpiHb e{p.H8}; pg8::gemm_phase<true, true>(LDSP, D / 2, (size_t)2048 * D, S, e); } if (16 + 1 < p.ph_hi) GSYNC(16); }
    if (p.ph_lo <= 17 && 17 < p.ph_hi) { { SchedMoeDown S{p.H8, p.Wd8 + (size_t)NE * 1024 * HID, CAP1 / 256, (int)gridDim.x, (int)blockIdx.x}; EpiYMb e{p.XgY, p.gatev, CAP1 / 256}; pg8::gemm_phase<true, false>(LDSP, HID / 2, (size_t)128 * HID, S, e); } if (17 + 1 < p.ph_hi) GSYNC(17); }
    if (p.ph_lo <= 18 && 18 < p.ph_hi) { phase_post_ffn<1>(p); if (18 + 1 < p.ph_hi) GSYNC(18); }
}

extern "C" void kernel_launch(void* const* d_in, const int* in_sizes, int n_in, void* d_out, int out_size, void* d_ws, size_t ws_size, hipStream_t stream) {
    constexpr size_t MiB = 1u << 20;
    static int grid = 0;
    if (grid == 0) {
        if (n_in != 18 || out_size != NL * D || ws_size < 960 * MiB) { fprintf(stderr, "kernel_launch: unexpected shapes n_in=%d out=%d ws=%zu\n", n_in, out_size, ws_size); grid = -1; return; }
        int dev = 0, cus = 0, per_cu = 0;
        hipGetDevice(&dev); hipDeviceGetAttribute(&cus, hipDeviceAttributeMultiprocessorCount, dev);
        hipFuncSetAttribute((const void*)fwd_kernel, hipFuncAttributeMaxDynamicSharedMemorySize, LDS_BYTES);
        hipOccupancyMaxActiveBlocksPerMultiprocessor(&per_cu, (const void*)fwd_kernel, NTHR, LDS_BYTES);
        if (per_cu < 1) { fprintf(stderr, "kernel_launch: occupancy query says %d blocks/CU\n", per_cu); per_cu = 1; }
        grid = cus;
        (void)hipGetLastError();
    }
    if (grid < 0) return;
    char* ws = (char*)d_ws;
    P p{};
    p.x = (const float*)d_in[0]; p.c = (const float*)d_in[1]; p.ctx = (const float*)d_in[2]; p.c_ctx = (const float*)d_in[3]; p.ada_w = (const float*)d_in[4]; p.ada_b = (const float*)d_in[5];
    p.norm_g = (const float*)d_in[6]; p.na_wqkv = (const float*)d_in[7]; p.na_wout = (const float*)d_in[8]; p.na_relb = (const float*)d_in[9]; p.ml_win = (const float*)d_in[10]; p.ml_bgate = (const float*)d_in[11];
    p.ml_normw = (const float*)d_in[12]; p.ml_wout = (const float*)d_in[13]; p.moe_wr = (const float*)d_in[14]; p.moe_wg = (const float*)d_in[15]; p.moe_wu = (const float*)d_in[16]; p.moe_wd = (const float*)d_in[17];
    p.out = (float*)d_out; p.ctl = (unsigned*)ws; p.xs = (bf16_t*)(ws + 880 * MiB);
    (void)hipMemsetAsync(ws, 0, 65536, stream);
    p.mod = (float*)(ws + 1 * MiB); p.rope = (float*)(ws + 2 * MiB); p.aff = (float*)(ws + 3 * MiB); p.inv = (int*)(ws + 6 * MiB); p.list = (int*)(ws + 9 * MiB); p.gatev = (float*)(ws + 10 * MiB);
    p.gates = (float*)(ws + 11 * MiB); p.xc = (float*)(ws + 16 * MiB);
    p.Wqkv_t = (bf16_t*)(ws + 24 * MiB); p.Wo0_t = (bf16_t*)(ws + 30 * MiB); p.Win_t = (bf16_t*)(ws + 32 * MiB); p.Wo1_t = (bf16_t*)(ws + 39 * MiB);
    p.Wgu8 = (fp8_t*)(ws + 48 * MiB); p.Wd8 = (fp8_t*)(ws + 176 * MiB);
    char* r1 = ws + 256 * MiB;
    p.h = (bf16_t*)r1; p.h8 = (fp8_t*)r1; p.Wqkv8 = (fp8_t*)(ws + 24 * MiB); p.Win8 = (fp8_t*)(ws + 32 * MiB); p.q = (bf16_t*)(r1 + 68 * MiB); p.k = (bf16_t*)(r1 + 136 * MiB); p.vT = (bf16_t*)(r1 + 204 * MiB); p.o = (bf16_t*)(r1 + 272 * MiB);
    p.H = (bf16_t*)r1; p.H8 = (fp8_t*)r1; p.dryx = (float*)(r1 + 136 * MiB);
    p.qm = (bf16_t*)(r1 + 68 * MiB); p.km = (bf16_t*)(r1 + 102 * MiB); p.vm = (bf16_t*)(r1 + 136 * MiB); p.om = (bf16_t*)(r1 + 204 * MiB); p.hf = (bf16_t*)(r1 + 272 * MiB); p.ro = (bf16_t*)(r1 + 68 * MiB);
    p.y = (bf16_t*)(ws + 596 * MiB); p.hb = p.y; p.h2 = (bf16_t*)(ws + 664 * MiB); p.h28 = (fp8_t*)(ws + 664 * MiB); p.XgY = (bf16_t*)(ws + 732 * MiB); p.Xg8 = (fp8_t*)(ws + 732 * MiB);
#if ONE_LAUNCH
    {
#if REP_PHASE >= 0
        const int nl = 3; const int los[3] = {0, REP_PHASE, REP_PHASE}, his[3] = {REP_PHASE, REP_PHASE + 1, NPHASE}; const int drys[3] = {0, 1, 0};
#else
        const int nl = 1; const int los[1] = {0}, his[1] = {NPHASE}; const int drys[1] = {0};
#endif
        for (int li = 0; li < nl; ++li) {
            if (los[li] >= his[li]) continue;
            p.ph_lo = los[li]; p.ph_hi = his[li]; p.dry = drys[li]; p.ctl = (unsigned*)ws + li * 4096;
            void* args[] = {&p};
            hipError_t e = hipLaunchCooperativeKernel((const void*)fwd_kernel, dim3(grid), dim3(NTHR), args, LDS_BYTES, stream);
            if (e != hipSuccess) fprintf(stderr, "cooperative launch failed: %s (grid %d)\n", hipGetErrorString(e), grid);
        }
    }
#else
    for (int ph = 0; ph < NPHASE; ++ph) { p.ph_lo = ph; p.ph_hi = ph + 1; hipLaunchKernelGGL(fwd_kernel, dim3(grid), dim3(NTHR), LDS_BYTES, stream, p); }
#endif
}
```
